# Optimizing an MI355X kernel written in HIP

```python
import functools
import jax
import jax.numpy as jnp
from jax import lax
import numpy as np

D_MODEL = 2048
BATCH = 2
SEQ = 4096
DEPTH = 1
DEC_BATCH = 32
DEC_SEQ = 8
PAST_LEN = 16384
PAGE_SIZE = 128

PLE_DIM = 256
HEAD_DIM = 64
N_Q_HEADS = D_MODEL // 128
N_KV_HEADS = N_Q_HEADS // 4
GQA_GROUP = N_Q_HEADS // N_KV_HEADS
ATTN_WIDTH = N_Q_HEADS * HEAD_DIM
KV_WIDTH = N_KV_HEADS * HEAD_DIM
WINDOW = 128
ALIBI_MAX = 8.0
R_HEAD = 64
R_WIDTH = D_MODEL // 2
R_HEADS = R_WIDTH // R_HEAD
DECAY_LORA = 64
AAA_LORA = 64
GATE_LORA = 160
RWKV_COLS = 3 * R_WIDTH + DECAY_LORA + AAA_LORA + GATE_LORA
IN_COLS = ATTN_WIDTH + 2 * KV_WIDTH + RWKV_COLS + 2 * D_MODEL
IN_SPLITS = (ATTN_WIDTH, ATTN_WIDTH + KV_WIDTH, ATTN_WIDTH + 2 * KV_WIDTH,
             ATTN_WIDTH + 2 * KV_WIDTH + RWKV_COLS, ATTN_WIDTH + 2 * KV_WIDTH + RWKV_COLS + D_MODEL)
R_SPLITS = (R_WIDTH, 2 * R_WIDTH, 3 * R_WIDTH, 3 * R_WIDTH + DECAY_LORA, 3 * R_WIDTH + DECAY_LORA + AAA_LORA)
D_FF = 4 * D_MODEL
NORM_EPS = 1e-6
GN_EPS = 64e-5

kernel_name = 'hybrid_swa_sink_rwkv7_step'


def rms_norm(x, g):
    x32 = x.astype(jnp.float32)
    y = x32 * lax.rsqrt(jnp.mean(x32 * x32, axis=-1, keepdims=True) + NORM_EPS)
    return (y * g.astype(jnp.float32)).astype(x.dtype)


def alibi_slopes():
    h = jnp.arange(1, N_Q_HEADS + 1, dtype=jnp.float32)
    return jnp.exp2(-ALIBI_MAX * h / N_Q_HEADS).reshape(N_KV_HEADS, GQA_GROUP)


def sink_attention(q, k, v, dist, valid, sinks):
    s = jnp.einsum('bnqhgd,bnshd->bnhgqs', q, k).astype(jnp.float32) * (HEAD_DIM ** -0.5)
    s = s - alibi_slopes()[None, None, :, :, None, None] * dist[None, :, None, None]
    s = jnp.where(valid[None, :, None, None], s, -jnp.inf)
    sink = sinks.astype(jnp.float32).reshape(N_KV_HEADS, GQA_GROUP)[None, None, :, :, None, None]
    m = jnp.maximum(jnp.max(s, axis=-1, keepdims=True), sink)
    p = jnp.exp(s - m)
    probs = p / (jnp.sum(p, axis=-1, keepdims=True) + jnp.exp(sink - m))
    return jnp.einsum('bnhgqs,bnshd->bnqhgd', probs.astype(v.dtype), v)


def window_attention_prompt(q, k, v, sinks):
    b, t = q.shape[0], q.shape[1]
    nb = t // WINDOW
    qb = q.reshape(b, nb, WINDOW, N_KV_HEADS, GQA_GROUP, HEAD_DIM)

    def band(z):
        pad = jnp.zeros((b, WINDOW, N_KV_HEADS, HEAD_DIM), z.dtype)
        zb = jnp.concatenate([pad, z], axis=1).reshape(b, nb + 1, WINDOW, N_KV_HEADS, HEAD_DIM)
        return jnp.concatenate([zb[:, :-1], zb[:, 1:]], axis=2)

    qi = jnp.arange(WINDOW)[:, None]
    kj = jnp.arange(2 * WINDOW)[None, :]
    dist = qi - kj + WINDOW
    key_pos = jnp.arange(nb)[:, None, None] * WINDOW - WINDOW + kj[None]
    valid = (dist >= 0) & (dist <= WINDOW) & (key_pos >= 0)
    o = sink_attention(qb, band(k), band(v), dist[None].astype(jnp.float32), valid, sinks)
    return o.reshape(b, t, ATTN_WIDTH), k[:, -WINDOW:], v[:, -WINDOW:]


def window_attention_sample(k_buf, v_buf, q, k, v, sinks):
    b, t = q.shape[0], q.shape[1]
    kf = jnp.concatenate([k_buf.astype(k.dtype), k], axis=1)
    vf = jnp.concatenate([v_buf.astype(v.dtype), v], axis=1)
    qi = jnp.arange(t)[:, None]
    kj = jnp.arange(WINDOW + t)[None, :]
    dist = qi - kj + WINDOW
    valid = (dist >= 0) & (dist <= WINDOW)
    o = sink_attention(q[:, None], kf[:, None], vf[:, None], dist[None].astype(jnp.float32), valid[None], sinks)
    return o.reshape(b, t, ATTN_WIDTH), kf[:, -WINDOW:], vf[:, -WINDOW:]


def wkv_scan(r, w, k, v, kk, a, s0):
    seq = tuple(jnp.moveaxis(z, 1, 0) for z in (r, w, k, v, kk, a))

    def step(S, inp):
        r_t, w_t, k_t, v_t, kk_t, a_t = inp
        sa = jnp.einsum('bhvk,bhk->bhv', S, -kk_t)
        S = (S * w_t[:, :, None, :] + sa[..., None] * (kk_t * a_t)[:, :, None, :]
             + v_t[..., None] * k_t[:, :, None, :])
        return S, jnp.einsum('bhvk,bhk->bhv', S, r_t)

    S, y = lax.scan(step, s0.astype(jnp.float32), seq)
    return jnp.moveaxis(y, 0, 1), S


def rwkv_time_mix(cols, prev, s0, mu, w0, w2, a0, a2, g2, k_k, k_a, r_k, ln_w, ln_b):
    b, t = cols.shape[0], cols.shape[1]
    f32 = jnp.float32
    shifted = jnp.concatenate([prev[:, None].astype(cols.dtype), cols[:, :-1]], axis=1)
    xx = cols + (shifted - cols) * mu
    r, k, v, wd, ad, gd = jnp.split(xx, R_SPLITS, axis=-1)
    wlog = -jax.nn.softplus(-(w0 + jnp.tanh(wd) @ w2).astype(f32)) - 0.5
    decay = jnp.exp(-jnp.exp(wlog))
    a = jax.nn.sigmoid((a0 + ad @ a2).astype(f32))
    g = jax.nn.sigmoid(gd) @ g2

    def heads(z):
        return z.reshape(b, t, R_HEADS, R_HEAD)

    kk = heads((k * k_k).astype(f32))
    kk = kk * lax.rsqrt(jnp.maximum(jnp.sum(kk * kk, axis=-1, keepdims=True), 1e-24))
    k32 = heads(k.astype(f32) * (1.0 + (a - 1.0) * k_a))
    r32 = heads(r.astype(f32))
    v32 = heads(v.astype(f32))
    y, S = wkv_scan(r32, heads(decay), k32, v32, kk, heads(a), s0)
    mean = jnp.mean(y, axis=-1, keepdims=True)
    var = jnp.mean(jnp.square(y - mean), axis=-1, keepdims=True)
    y = (y - mean) * lax.rsqrt(var + GN_EPS) * ln_w.reshape(R_HEADS, R_HEAD) + ln_b.reshape(R_HEADS, R_HEAD)
    y = y + jnp.sum(r32 * k32 * r_k, axis=-1, keepdims=True) * v32
    y = y.reshape(b, t, R_WIDTH).astype(cols.dtype) * g
    return y, S, cols[:, -1]


def run_layer(x, pe, attend, s0, prev, lw):
    (norm_mix, w_in, attn_sinks, rwkv_mu, rwkv_w0, rwkv_w2, rwkv_a0, rwkv_a2, rwkv_g2,
     rwkv_k_k, rwkv_k_a, rwkv_r_k, rwkv_ln_w, rwkv_ln_b, w_branch_attn, w_branch_rwkv,
     w_out, norm_ffn, w_ff_up, w_ff_down, w_ple_proj, w_ple_gate) = lw
    b, t = x.shape[0], x.shape[1]
    h = rms_norm(x, norm_mix)
    proj = h @ w_in
    q, k, v, cols, gate_a, gate_r = jnp.split(proj, IN_SPLITS, axis=-1)
    q = q.reshape(b, t, N_KV_HEADS, GQA_GROUP, HEAD_DIM)
    k = k.reshape(b, t, N_KV_HEADS, HEAD_DIM)
    v = v.reshape(b, t, N_KV_HEADS, HEAD_DIM)
    y_a, k_buf, v_buf = attend(q, k, v, attn_sinks)
    y_r, s_new, prev_new = rwkv_time_mix(cols, prev, s0, rwkv_mu, rwkv_w0, rwkv_w2, rwkv_a0, rwkv_a2,
                                         rwkv_g2, rwkv_k_k, rwkv_k_a, rwkv_r_k, rwkv_ln_w, rwkv_ln_b)
    mixed = (jax.nn.sigmoid(gate_a) * (y_a @ w_branch_attn)
             + jax.nn.sigmoid(gate_r) * (y_r @ w_branch_rwkv))
    x = x + mixed @ w_out
    u = rms_norm(x, norm_ffn) @ w_ff_up
    x = x + jnp.square(jax.nn.relu(u)) @ w_ff_down
    x = x + jax.nn.sigmoid(x @ w_ple_gate) * (pe @ w_ple_proj)
    return x, k_buf, v_buf, s_new.astype(x.dtype), prev_new


def setup_inputs(seed: int = 0) -> dict:
    key = jax.random.key(seed)
    ks = list(jax.random.split(key, 48))
    f32 = jnp.float32
    L = DEPTH

    def nk():
        return ks.pop()

    def normal(shape, scale=1.0):
        return jax.random.normal(nk(), shape, f32) * scale

    def dense(shape, fan_in, scale=1.0):
        return normal(shape, scale * fan_in ** -0.5)

    def gain(shape):
        return 1.0 + normal(shape, 0.01)

    return {
        'x_prompt': normal((BATCH, SEQ, D_MODEL)),
        'x_sample': normal((DEC_BATCH, DEC_SEQ, D_MODEL)),
        'cache_k_win': normal((L, DEC_BATCH, WINDOW, N_KV_HEADS, HEAD_DIM)),
        'cache_v_win': normal((L, DEC_BATCH, WINDOW, N_KV_HEADS, HEAD_DIM)),
        'state_wkv': normal((L, DEC_BATCH, R_HEADS, R_HEAD, R_HEAD), 0.5),
        'state_shift': normal((L, DEC_BATCH, RWKV_COLS)),
        'p_prompt': normal((L, BATCH, SEQ, PLE_DIM)),
        'p_sample': normal((L, DEC_BATCH, DEC_SEQ, PLE_DIM)),
        'norm_mix': gain((L, D_MODEL)),
        'w_in': dense((L, D_MODEL, IN_COLS), D_MODEL),
        'attn_sinks': normal((L, N_Q_HEADS)),
        'rwkv_mu': jax.random.uniform(nk(), (L, RWKV_COLS), f32),
        'rwkv_w0': jax.random.uniform(nk(), (L, R_WIDTH), f32, -6.0, 1.0),
        'rwkv_w2': dense((L, DECAY_LORA, R_WIDTH), DECAY_LORA, 0.1),
        'rwkv_a0': normal((L, R_WIDTH), 0.1),
        'rwkv_a2': dense((L, AAA_LORA, R_WIDTH), AAA_LORA, 0.1),
        'rwkv_g2': dense((L, GATE_LORA, R_WIDTH), GATE_LORA),
        'rwkv_k_k': 0.85 + normal((L, R_WIDTH), 0.02),
        'rwkv_k_a': 1.0 + normal((L, R_WIDTH), 0.02),
        'rwkv_r_k': normal((L, R_HEADS, R_HEAD), 0.1),
        'rwkv_ln_w': gain((L, R_WIDTH)),
        'rwkv_ln_b': normal((L, R_WIDTH), 0.01),
        'w_branch_attn': dense((L, ATTN_WIDTH, D_MODEL), ATTN_WIDTH),
        'w_branch_rwkv': dense((L, R_WIDTH, D_MODEL), R_WIDTH),
        'w_out': dense((L, D_MODEL, D_MODEL), D_MODEL),
        'norm_ffn': gain((L, D_MODEL)),
        'w_ff_up': dense((L, D_MODEL, D_FF), D_MODEL),
        'w_ff_down': dense((L, D_FF, D_MODEL), D_FF),
        'w_ple_proj': dense((L, PLE_DIM, D_MODEL), PLE_DIM),
        'w_ple_gate': dense((L, D_MODEL, D_MODEL), D_MODEL),
        'norm_final': gain((D_MODEL,)),
    }


def reference(x_prompt, x_sample, cache_k_win, cache_v_win, state_wkv, state_shift, p_prompt, p_sample,
              norm_mix, w_in, attn_sinks, rwkv_mu, rwkv_w0, rwkv_w2, rwkv_a0, rwkv_a2, rwkv_g2,
              rwkv_k_k, rwkv_k_a, rwkv_r_k, rwkv_ln_w, rwkv_ln_b, w_branch_attn, w_branch_rwkv,
              w_out, norm_ffn, w_ff_up, w_ff_down, w_ple_proj, w_ple_gate, norm_final):
    xp, xs = x_prompt, x_sample
    bp = x_prompt.shape[0]
    kp_l, vp_l, sp_l, hp_l = [], [], [], []
    ks_l, vs_l, ss_l, hs_l = [], [], [], []
    for i in range(DEPTH):
        lw = (norm_mix[i], w_in[i], attn_sinks[i], rwkv_mu[i], rwkv_w0[i], rwkv_w2[i], rwkv_a0[i],
              rwkv_a2[i], rwkv_g2[i], rwkv_k_k[i], rwkv_k_a[i], rwkv_r_k[i], rwkv_ln_w[i], rwkv_ln_b[i],
              w_branch_attn[i], w_branch_rwkv[i], w_out[i], norm_ffn[i], w_ff_up[i], w_ff_down[i],
              w_ple_proj[i], w_ple_gate[i])
        s0_p = jnp.zeros((bp, R_HEADS, R_HEAD, R_HEAD), jnp.float32)
        prev_p = jnp.zeros((bp, RWKV_COLS), xp.dtype)
        xp, kb, vb, sn, hn = run_layer(xp, p_prompt[i], window_attention_prompt, s0_p, prev_p, lw)
        kp_l.append(kb); vp_l.append(vb); sp_l.append(sn); hp_l.append(hn)
        attend_s = functools.partial(window_attention_sample, cache_k_win[i], cache_v_win[i])
        xs, kb, vb, sn, hn = run_layer(xs, p_sample[i], attend_s, state_wkv[i], state_shift[i], lw)
        ks_l.append(kb); vs_l.append(vb); ss_l.append(sn); hs_l.append(hn)
    y_prompt = rms_norm(xp, norm_final)
    y_sample = rms_norm(xs, norm_final)
    new_k_win_prompt = jnp.stack(kp_l)
    new_v_win_prompt = jnp.stack(vp_l)
    new_wkv_prompt = jnp.stack(sp_l)
    new_shift_prompt = jnp.stack(hp_l)
    new_k_win_sample = jnp.stack(ks_l)
    new_v_win_sample = jnp.stack(vs_l)
    new_wkv_sample = jnp.stack(ss_l)
    new_shift_sample = jnp.stack(hs_l)
    return (y_prompt, y_sample, new_k_win_prompt, new_v_win_prompt, new_wkv_prompt, new_shift_prompt,
            new_k_win_sample, new_v_win_sample, new_wkv_sample, new_shift_sample)
```

```cpp
#include <hip/hip_runtime.h>
#include <hip/hip_cooperative_groups.h>
#include <cstdio>
namespace cg = cooperative_groups;

#define LAS __attribute__((address_space(3)))
typedef unsigned short bf16_t;
typedef short bf16x8 __attribute__((ext_vector_type(8)));
typedef float f32x4 __attribute__((ext_vector_type(4)));
typedef float f32x2 __attribute__((ext_vector_type(2)));
typedef unsigned u32x4 __attribute__((ext_vector_type(4)));
typedef unsigned u32x2 __attribute__((ext_vector_type(2)));

constexpr int BM = 256, BK = 64, HALF = 128, HTB = HALF * BK * 2, STAGE_BYTES = 8 * HTB, NXCD = 8, WGM = 8;
constexpr int MTOK = 8448, MPR = 8192, DM = 2048, RC = 3360, RCL = 3584;
constexpr size_t LDS_BYTES = 147456;

constexpr size_t WT_BA = 0, WT_BR = 4194304, WT_OUT = 8388608, WT_UP = 16777216, WT_DN = 50331648, WT_PP = 83886080, WT_PG = 84934656, WT_LORA = 93323264;
constexpr size_t R12 = 95682560;
constexpr size_t WT_IN = R12, HBUF = R12 + 37748736;
constexpr size_t LORA_OUT = R12, YA = R12 + 51904512;
constexpr size_t MIXED = R12, HN = R12 + 34603008, X2B = R12;
constexpr size_t R3 = 168034304;
constexpr size_t QB = R3, KP = R3 + 17301504, VP = KP + 4194304, KS = VP + 4194304, VS = KS + 2359296;
constexpr size_t YRAW = R3, SREC = R3 + 8388608, YRAW_S = SREC + 6291456;
constexpr size_t ACTB = R3, PBUF = R12 + 34603008;
constexpr size_t SEG = 198443008, SEG_SZ = 25165824;
constexpr size_t YR = 248774656;
constexpr size_t GA = 266076160, GR = 300679168, X1 = GA;
constexpr size_t SSQ1 = 335282176, SSQ2 = SSQ1 + 1081344, BON = SSQ2 + 1081344, PEB = BON + 1081344;
constexpr size_t XBAR = PEB + 4325376;
constexpr size_t RSB = XBAR + 16384;
constexpr size_t WS_END = RSB + 2097152;
constexpr size_t O_COLS = 0, O_LORA_A = 60555264;
constexpr size_t O_KWP = 17301504, O_VWP = 17367040, O_WKVP = 17432576, O_SHP = 17563648, O_KWS = 17570368, O_VWS = 18618944, O_WKVS = 19667520, O_SHS = 21764672;
constexpr int ACT_SPLIT = 15;

#ifndef PHMASK
#define PHMASK 0x7ff
#endif
struct Params { const float* in[31]; float* out; char* ws; };
typedef const Params __attribute__((address_space(4)))* PP;
__device__ __forceinline__ PP fresh_params() { PP p = (PP)__builtin_amdgcn_kernarg_segment_ptr(); asm volatile("" : "+s"(p)); return p; }
__device__ __forceinline__ int opaque(int k) { asm volatile("" : "+s"(k)); return k; }

typedef __bf16 bf16x2_t __attribute__((ext_vector_type(2)));
__device__ __forceinline__ unsigned cvt_pk_bf16(float lo, float hi) { f32x2 v = {lo, hi}; bf16x2_t b = __builtin_convertvector(v, bf16x2_t); return __builtin_bit_cast(unsigned, b); }
__device__ __forceinline__ float bf2f(unsigned short b) { return __uint_as_float(((unsigned)b) << 16); }
__device__ __forceinline__ float bflo(unsigned w) { return __uint_as_float(w << 16); }
__device__ __forceinline__ float bfhi(unsigned w) { return __uint_as_float(w & 0xffff0000u); }
__device__ __forceinline__ u32x2 pack4(f32x4 v) { u32x2 w; w.x = cvt_pk_bf16(v[0], v[1]); w.y = cvt_pk_bf16(v[2], v[3]); return w; }
__device__ __forceinline__ f32x4 unpack4(u32x2 w) { return (f32x4){bflo(w.x), bfhi(w.x), bflo(w.y), bfhi(w.y)}; }
__device__ __forceinline__ float sigmoidf_(float x) { return __builtin_amdgcn_rcpf(1.0f + __expf(-x)); }
__device__ __forceinline__ float wave_sum(float x) {
#pragma unroll
    for (int o = 1; o < 64; o <<= 1) x += __shfl_xor(x, o);
    return x;
}
__device__ __forceinline__ float dppf(float x, const int ctrl) { return x; }
#define DPPX(x, ctrl) __builtin_bit_cast(float, __builtin_amdgcn_update_dpp(0, __builtin_bit_cast(int, (x)), (ctrl), 0xF, 0xF, true))
#define DPP_ADD(x, ctrl) ((x) + __builtin_bit_cast(float, __builtin_amdgcn_update_dpp(0, __builtin_bit_cast(int, (x)), (ctrl), 0xF, 0xF, true)))
__device__ __forceinline__ float row16_sum(float x) {
    x = DPP_ADD(x, 0xB1); x = DPP_ADD(x, 0x4E); x = DPP_ADD(x, 0x141); x = DPP_ADD(x, 0x140); return x;
}

__host__ __device__ __forceinline__ int lds_byte(int r, int c) { const int st = (r >> 4) * 2 + (c >> 5), rr = r & 15, cc = c & 31, ob = rr * 64 + cc * 2; return st * 1024 + (ob ^ (((ob >> 9) & 1) << 5)); }
__host__ __device__ __forceinline__ void stage_rc(int b, int& R, int& C) { const int st = b / 1024, sb = b % 1024, swz = sb ^ (((sb >> 9) & 1) << 5); R = (st >> 1) * 16 + swz / 64; C = (st & 1) * 32 + (swz % 64) / 2; }

struct Unit { int pm, pn, sub, zero, ui, nt, part; const char* A; const char* B; };
struct Sched {
    int nM, nN, nwg, G, c, dual, splitpm, ntfull, tail, sk, ntslice; size_t tstep; float* part; int tail_i, partld, ngem, nosub;
    const char *A0, *A0b, *B0, *A1, *B1;
    __device__ __forceinline__ void init(int M, int N, int K, const void* A, const void* B) { nM = M / BM; nN = N / BM; nwg = nM * nN; G = gridDim.x; c = blockIdx.x; dual = 0; splitpm = 1 << 30; ntfull = K / BK; tail = 0; sk = 1; ntslice = 0; part = nullptr; ngem = 1; nosub = 0; tstep = (size_t)BM * K * 2; A0 = (const char*)A; A0b = A0; B0 = (const char*)B; A1 = A0; B1 = B0; }
    __device__ __forceinline__ void set_tail(int sk_) { tail = 1; sk = sk_; ntslice = ntfull / sk_; nM = 32; nwg = nM * nN; tail_i = (dual ? 2 : 1) * (nwg / G); partld = nN * BM; ngem = dual ? 2 : 1; }
    __device__ __forceinline__ bool next(int i, Unit& u) const {
        if (tail && i >= tail_i) {
            const int j = c, nsl = ngem * sk;
            if (nosub || i != tail_i || j >= nN * nsl) return false;
            const int sl = j / nN; u.pn = j % nN; u.pm = 32; u.sub = sl / sk; u.zero = 1; u.ui = i; u.nt = ntslice; u.part = sl;
            const size_t koff = (size_t)(sl % sk) * ntslice * BK * 2;
            const char* ab = u.sub ? A1 : (u.pm >= splitpm ? A0b - (size_t)splitpm * tstep : A0);
            u.A = ab + (size_t)u.pm * tstep + koff; u.B = (u.sub ? B1 : B0) + (size_t)u.pn * tstep + koff;
            return true;
        }
        const int ti = dual ? (i >> 1) : i;
        const long L = (long)ti * G + c; if (L >= nwg) return false;
        int wgid = (int)L; { const int q = nwg / NXCD, r = nwg % NXCD, xcd = wgid % NXCD, off = wgid / NXCD; wgid = (xcd < r ? xcd * (q + 1) : r * (q + 1) + (xcd - r) * q) + off; }
        const int nig = WGM * nN, gid = wgid / nig, fm = gid * WGM, gsz = (nM - fm) < WGM ? (nM - fm) : WGM;
        u.pm = fm + ((wgid % nig) % gsz); u.pn = (wgid % nig) / gsz;
        u.sub = dual ? (i & 1) : 0; u.zero = (u.sub == 0); u.ui = i; u.nt = ntfull; u.part = -1;
        const char* ab = u.sub ? A1 : (u.pm >= splitpm ? A0b - (size_t)splitpm * tstep : A0);
        u.A = ab + (size_t)u.pm * tstep; u.B = (u.sub ? B1 : B0) + (size_t)u.pn * tstep;
        return true;
    }
};

template <class Epi>
__device__ __forceinline__ void gemm_phase(LAS unsigned char* lds, const int K, const Sched& S, const Epi& E) {
    int tid = threadIdx.x; asm volatile("" : "+v"(tid));
    const int wid = __builtin_amdgcn_readfirstlane(tid >> 6), lane = tid & 63, wr = wid >> 2, wc = wid & 3, fr = lane & 15, fq = lane >> 4;
    unsigned voffA[2], voffB[2];
#pragma unroll
    for (int i = 0; i < 2; ++i) { int R, C; stage_rc(tid * 16 + i * 8192, R, C); voffA[i] = (unsigned)(R * K + C) * 2u;
        const int rho = R & 31, Rb = (R & ~31) + 8 * ((rho & 15) >> 2) + 4 * (rho >> 4) + (rho & 3); voffB[i] = (unsigned)(Rb * K + C) * 2u; }
    const size_t kstep = (size_t)(BK * 2);
    const size_t hstep = (size_t)HALF * K * 2;
    const unsigned ldsw = (unsigned)wid * 1024u;
    const int aoff = lds_byte(wr * 64 + fr, fq * 8), boff = lds_byte(wc * 32 + fr, fq * 8);
#define PG8_SA(b, h) (((b) * 2 + (h)) * HTB)
#define PG8_SB(b, h) ((4 + (b) * 2 + (h)) * HTB)
#define PG8_STAGE(bufoff, gbase, voff) do { _Pragma("unroll") for (int _i = 0; _i < 2; ++_i) \
        __builtin_amdgcn_global_load_lds((const unsigned*)((const char*)(gbase) + (voff)[_i]), (LAS unsigned*)(lds + (bufoff) + ldsw + _i * 8192), 16, 0, 0); } while (0)
#define PG8_LDA(dst, b, h) do { _Pragma("unroll") for (int m = 0; m < 4; ++m) _Pragma("unroll") for (int k = 0; k < 2; ++k) dst[m][k] = *(const LAS bf16x8*)(lds + PG8_SA(b, h) + aoff + m * 2048 + k * 1024); } while (0)
#define PG8_LDB(dst, b, h) do { _Pragma("unroll") for (int n = 0; n < 2; ++n) _Pragma("unroll") for (int k = 0; k < 2; ++k) dst[n][k] = *(const LAS bf16x8*)(lds + PG8_SB(b, h) + boff + n * 2048 + k * 1024); } while (0)
#define PG8_MMA(ai, bj, At, Bt) do { __builtin_amdgcn_s_setprio(1); _Pragma("unroll") for (int m = 0; m < 4; ++m) _Pragma("unroll") for (int n = 0; n < 2; ++n) _Pragma("unroll") for (int k = 0; k < 2; ++k) \
        acc[ai][bj][m][n] = __builtin_amdgcn_mfma_f32_16x16x32_bf16(Bt[n][k], At[m][k], acc[ai][bj][m][n], 0, 0, 0); __builtin_amdgcn_s_setprio(0); } while (0)
#define PG8_WAIT_V(n) asm volatile("s_waitcnt vmcnt(" #n ")" ::: "memory")
#define PG8_WAIT_L(n) asm volatile("s_waitcnt lgkmcnt(" #n ")" ::: "memory")
#define PG8_BAR __builtin_amdgcn_s_barrier()
#define PG8_SCHED __builtin_amdgcn_sched_barrier(0)
    Unit cur, nxt; int ui = 0;
    if (!S.next(0, cur)) return;
    f32x4 acc[2][2][4][2];
#pragma unroll
    for (int a = 0; a < 2; ++a)
#pragma unroll
        for (int b = 0; b < 2; ++b)
#pragma unroll
            for (int m = 0; m < 4; ++m)
#pragma unroll
                for (int n = 0; n < 2; ++n) acc[a][b][m][n] = (f32x4){0.f, 0.f, 0.f, 0.f};
    bf16x8 At[4][2], B0[2][2], B1[2][2];
    const char* cA = cur.A; const char* cB = cur.B;
    PG8_STAGE(PG8_SB(0, 0), cB, voffB); PG8_STAGE(PG8_SA(0, 0), cA, voffA); PG8_STAGE(PG8_SB(0, 1), cB + hstep, voffB); PG8_STAGE(PG8_SA(0, 1), cA + hstep, voffA);
    if (wr == 1) PG8_BAR;
    PG8_WAIT_V(4); PG8_BAR;
    PG8_STAGE(PG8_SB(1, 0), cB + kstep, voffB); PG8_STAGE(PG8_SA(1, 0), cA + kstep, voffA); PG8_STAGE(PG8_SB(1, 1), cB + hstep + kstep, voffB);
    PG8_WAIT_V(6); PG8_BAR;
    for (;;) {
        const bool has_next = S.next(ui + 1, nxt);
        const char* nA = has_next ? nxt.A : cA; const char* nB = has_next ? nxt.B : cB;
        const int nt = cur.nt;
        for (int t = 0; t < nt; t += 2) {
            const bool last = (t == nt - 2);
            const char* a1 = cA + (size_t)(t + 1) * kstep;
            const char* a2 = last ? nA : cA + (size_t)(t + 2) * kstep; const char* b2 = last ? nB : cB + (size_t)(t + 2) * kstep;
            const char* a3 = a2 + kstep; const char* b3 = b2 + kstep;
            PG8_LDB(B0, 0, 0); PG8_SCHED; PG8_LDA(At, 0, 0); PG8_STAGE(PG8_SA(1, 1), a1 + hstep, voffA);
            PG8_WAIT_L(8); PG8_BAR; PG8_WAIT_L(0); PG8_MMA(0, 0, At, B0); PG8_BAR; PG8_SCHED;
            PG8_LDB(B1, 0, 1); PG8_STAGE(PG8_SB(0, 0), b2, voffB);
            PG8_BAR; PG8_WAIT_L(0); PG8_MMA(0, 1, At, B1); PG8_BAR;
            PG8_LDA(At, 0, 1); PG8_STAGE(PG8_SA(0, 0), a2, voffA);
            PG8_BAR; PG8_WAIT_L(0); PG8_MMA(1, 0, At, B0); PG8_BAR; PG8_SCHED;
            PG8_STAGE(PG8_SB(0, 1), b2 + hstep, voffB);
            PG8_WAIT_V(6); PG8_BAR; PG8_MMA(1, 1, At, B1); PG8_BAR;
            PG8_LDB(B0, 1, 0); PG8_SCHED; PG8_LDA(At, 1, 0); PG8_STAGE(PG8_SA(0, 1), a2 + hstep, voffA);
            PG8_WAIT_L(8); PG8_BAR; PG8_WAIT_L(0); PG8_MMA(0, 0, At, B0); PG8_BAR; PG8_SCHED;
            PG8_LDB(B1, 1, 1); PG8_STAGE(PG8_SB(1, 0), b3, voffB);
            PG8_BAR; PG8_WAIT_L(0); PG8_MMA(0, 1, At, B1); PG8_BAR;
            PG8_LDA(At, 1, 1); PG8_STAGE(PG8_SA(1, 0), a3, voffA);
            PG8_BAR; PG8_WAIT_L(0); PG8_MMA(1, 0, At, B0); PG8_BAR; PG8_SCHED;
            PG8_STAGE(PG8_SB(1, 1), b3 + hstep, voffB);
            PG8_WAIT_V(6); PG8_BAR; PG8_MMA(1, 1, At, B1); PG8_BAR;
        }
        if (cur.part >= 0) {
            float* pp = S.part + (size_t)cur.part * 256 * Epi::PARTLD + (size_t)(wr * 64 + fr) * Epi::PARTLD + cur.pn * 256 + wc * 32 + 8 * fq;
#pragma unroll
            for (int ai = 0; ai < 2; ++ai)
#pragma unroll
                for (int m = 0; m < 4; ++m)
#pragma unroll
                    for (int bj = 0; bj < 2; ++bj)
#pragma unroll
                        for (int n = 0; n < 2; ++n)
                            *(f32x4*)(pp + (size_t)(ai * HALF + m * 16) * Epi::PARTLD + bj * HALF + n * 4) = acc[ai][bj][m][n];
        } else E(acc, cur, wr, wc, fr, fq);
        if (!has_next) break;
        if (nxt.zero) {
#pragma unroll
            for (int a = 0; a < 2; ++a)
#pragma unroll
                for (int b = 0; b < 2; ++b)
#pragma unroll
                    for (int m = 0; m < 4; ++m)
#pragma unroll
                        for (int n = 0; n < 2; ++n) acc[a][b][m][n] = (f32x4){0.f, 0.f, 0.f, 0.f};
        }
        cur = nxt; cA = nA; cB = nB; ++ui;
    }
    PG8_WAIT_V(0);
    if (wr == 0) PG8_BAR;
    PG8_BAR;
#undef PG8_SA
#undef PG8_SB
#undef PG8_STAGE
#undef PG8_LDA
#undef PG8_LDB
#undef PG8_MMA
#undef PG8_WAIT_V
#undef PG8_WAIT_L
#undef PG8_BAR
#undef PG8_SCHED
}

#define EPI_LOOP_BEGIN \
    _Pragma("unroll") for (int ai = 0; ai < 2; ++ai) _Pragma("unroll") for (int m = 0; m < 4; ++m) { \
        const int r = u.pm * BM + ai * HALF + wr * 64 + m * 16 + fr; \
        _Pragma("unroll") for (int bj = 0; bj < 2; ++bj) _Pragma("unroll") for (int n = 0; n < 2; ++n) { \
            const int cl = bj * HALF + wc * 32 + 8 * fq + 4 * n; f32x4& v = acc[ai][bj][m][n];
#define EPI_LOOP_END } if (m == 3) asm volatile("" ::: "memory"); }

struct EpiIn {
    static constexpr int PARTLD = 2048;
    bf16_t *qb, *kp, *vp, *ks, *vs, *colsb, *ga, *gr; float* out;
    __device__ __forceinline__ void operator()(f32x4 (&acc)[2][2][4][2], const Unit& u, int wr, int wc, int fr, int fq) const {
        const int pn = u.pn;
        if (pn < 4) {
            EPI_LOOP_BEGIN *(u32x2*)(qb + (size_t)r * 1024 + pn * 256 + cl) = pack4(v); EPI_LOOP_END
        } else if (pn < 6) {
            bf16_t* dp = pn == 4 ? kp : vp; bf16_t* ds = pn == 4 ? ks : vs;
            float* owp = out + (pn == 4 ? O_KWP : O_VWP); float* ows = out + (pn == 4 ? O_KWS : O_VWS);
            EPI_LOOP_BEGIN
                if (r < MPR) { *(u32x2*)(dp + (size_t)r * 256 + cl) = pack4(v); const int b = r >> 12, t = r & 4095; if (t >= 3968) *(f32x4*)(owp + (size_t)(b * 128 + t - 3968) * 256 + cl) = v; }
                else { const int rs = r - MPR, b = rs >> 3, t = rs & 7; *(u32x2*)(ds + (size_t)(b * 144 + 128 + t) * 256 + cl) = pack4(v); *(f32x4*)(ows + (size_t)(b * 128 + 120 + t) * 256 + cl) = v; }
            EPI_LOOP_END
        } else if (pn < 20) {
            EPI_LOOP_BEGIN
                const int c = (pn - 6) * 256 + cl;
                if (c < RC) {
                    *(u32x2*)(colsb + (size_t)r * RCL + c) = pack4(v);
                    if (r < MPR) { if ((r & 4095) == 4095) *(f32x4*)(out + O_SHP + (size_t)(r >> 12) * RC + c) = v; }
                    else { if (((r - MPR) & 7) == 7) *(f32x4*)(out + O_SHS + (size_t)((r - MPR) >> 3) * RC + c) = v; }
                }
            EPI_LOOP_END
        } else {
            bf16_t* g = pn < 28 ? ga : gr; const int pb = pn < 28 ? 20 : 28;
            EPI_LOOP_BEGIN
                f32x4 s; s[0] = sigmoidf_(v[0]); s[1] = sigmoidf_(v[1]); s[2] = sigmoidf_(v[2]); s[3] = sigmoidf_(v[3]);
                *(u32x2*)(g + (size_t)r * DM + (pn - pb) * 256 + cl) = pack4(s);
            EPI_LOOP_END
        }
    }
};
struct EpiLora {
    static constexpr int PARTLD = 2048;
    bf16_t* o; const float *w0, *a0;
    __device__ __forceinline__ void operator()(f32x4 (&acc)[2][2][4][2], const Unit& u, int wr, int wc, int fr, int fq) const {
        const int grp = u.pn >> 2;
        EPI_LOOP_BEGIN
            const int c = u.pn * 256 + cl; f32x4 s = v;
            if (grp == 0) { const f32x4 b = *(const f32x4*)(w0 + c); _Pragma("unroll") for (int j = 0; j < 4; ++j) s[j] = sigmoidf_(v[j] + b[j]) * 0.60653066f; }
            else if (grp == 1) { const f32x4 b = *(const f32x4*)(a0 + c - 1024); _Pragma("unroll") for (int j = 0; j < 4; ++j) s[j] = sigmoidf_(v[j] + b[j]); }
            *(u32x2*)(o + (size_t)r * 3072 + c) = pack4(s);
        EPI_LOOP_END
    }
};
struct EpiMix {
    static constexpr int PARTLD = 2048;
    const bf16_t *ga, *gr; bf16_t* mixed; float* dbg;
    __device__ __forceinline__ void operator()(f32x4 (&acc)[2][2][4][2], const Unit& u, int wr, int wc, int fr, int fq) const {
        if (u.sub == 0) {
            EPI_LOOP_BEGIN
                const size_t o = (size_t)r * DM + u.pn * 256 + cl; const f32x4 a = unpack4(*(const u32x2*)(ga + o)), b = unpack4(*(const u32x2*)(gr + o));
                _Pragma("unroll") for (int j = 0; j < 4; ++j) v[j] *= a[j] * __builtin_amdgcn_rcpf(b[j]);
            EPI_LOOP_END
        } else {
            EPI_LOOP_BEGIN
                const size_t o = (size_t)r * DM + u.pn * 256 + cl; const f32x4 b = unpack4(*(const u32x2*)(gr + o));
                *(u32x2*)(mixed + o) = pack4(v * b);
#ifdef PROD_DUMP
                if ((r & 15) == 0) *(f32x4*)(dbg + 16000000 + (size_t)(r >> 4) * DM + u.pn * 256 + cl) = v * b;
#endif
            EPI_LOOP_END
        }
    }
};
struct EpiOut {
    static constexpr int PARTLD = 2048;
    const float *xp, *xs, *gn; float *x1, *ssq; bf16_t* hn;
    __device__ __forceinline__ void operator()(f32x4 (&acc)[2][2][4][2], const Unit& u, int wr, int wc, int fr, int fq) const {
#pragma unroll
        for (int ai = 0; ai < 2; ++ai)
#pragma unroll
            for (int m = 0; m < 4; ++m) {
                const int r = u.pm * BM + ai * HALF + wr * 64 + m * 16 + fr;
                const float* xr = r < MPR ? xp + (size_t)r * DM : xs + (size_t)(r - MPR) * DM; float ss = 0.f;
#pragma unroll
                for (int bj = 0; bj < 2; ++bj)
#pragma unroll
                    for (int n = 0; n < 2; ++n) {
                        const int c = u.pn * 256 + bj * HALF + wc * 32 + 8 * fq + 4 * n;
                        const f32x4 x = *(const f32x4*)(xr + c) + acc[ai][bj][m][n]; const f32x4 g = *(const f32x4*)(gn + c);
                        *(f32x4*)(x1 + (size_t)r * DM + c) = x; *(u32x2*)(hn + (size_t)r * DM + c) = pack4(x * g);
                        ss += x[0] * x[0] + x[1] * x[1] + x[2] * x[2] + x[3] * x[3];
                    }
                ss += __shfl_xor(ss, 16); ss += __shfl_xor(ss, 32);
                if (fq == 0) ssq[((size_t)u.pn * MTOK + r) * 4 + wc] = ss;
            }
    }
};
struct EpiUp {
    static constexpr int PARTLD = 8192;
    const float* rsb; bf16_t *actA, *actB;
    __device__ __forceinline__ void operator()(f32x4 (&acc)[2][2][4][2], const Unit& u, int wr, int wc, int fr, int fq) const {
        bf16_t* base = u.pm < ACT_SPLIT ? actA : actB - (size_t)ACT_SPLIT * BM * 8192;
        float rsv[2][4];
#pragma unroll
        for (int ai = 0; ai < 2; ++ai)
#pragma unroll
            for (int m = 0; m < 4; ++m) rsv[ai][m] = rsb[u.ui * 256 + ai * HALF + wr * 64 + m * 16 + fr];
#pragma unroll
        for (int ai = 0; ai < 2; ++ai)
#pragma unroll
            for (int m = 0; m < 4; ++m) {
                const int r = u.pm * BM + ai * HALF + wr * 64 + m * 16 + fr; const float rs = rsv[ai][m];
#pragma unroll
                for (int bj = 0; bj < 2; ++bj)
#pragma unroll
                    for (int n = 0; n < 2; ++n) {
                        const int c = u.pn * 256 + bj * HALF + wc * 32 + 8 * fq + 4 * n; f32x4 a = acc[ai][bj][m][n] * rs;
#pragma unroll
                        for (int j = 0; j < 4; ++j) { const float z = fmaxf(a[j], 0.f); a[j] = z * z; }
                        *(u32x2*)(base + (size_t)r * 8192 + c) = pack4(a);
                    }
            }
    }
};
struct EpiNone {
    static constexpr int PARTLD = 2048;
    __device__ __forceinline__ void operator()(f32x4 (&acc)[2][2][4][2], const Unit& u, int wr, int wc, int fr, int fq) const {}
};
struct EpiDown {
    static constexpr int PARTLD = 2048;
    float* x1; bf16_t* x2b;
    __device__ __forceinline__ void operator()(f32x4 (&acc)[2][2][4][2], const Unit& u, int wr, int wc, int fr, int fq) const {
        EPI_LOOP_BEGIN
            const size_t o = (size_t)r * DM + u.pn * 256 + cl; const f32x4 x = *(const f32x4*)(x1 + o) + v;
            *(f32x4*)(x1 + o) = x; *(u32x2*)(x2b + o) = pack4(x);
        EPI_LOOP_END
    }
};
struct EpiP {
    static constexpr int PARTLD = 2048;
    bf16_t* pb;
    __device__ __forceinline__ void operator()(f32x4 (&acc)[2][2][4][2], const Unit& u, int wr, int wc, int fr, int fq) const {
        EPI_LOOP_BEGIN *(u32x2*)(pb + (size_t)r * DM + u.pn * 256 + cl) = pack4(v); EPI_LOOP_END
    }
};
struct EpiGate {
    static constexpr int PARTLD = 2048;
    const float* x2; const bf16_t* pb; float *o, *ssq;
    __device__ __forceinline__ void operator()(f32x4 (&acc)[2][2][4][2], const Unit& u, int wr, int wc, int fr, int fq) const {
#pragma unroll
        for (int ai = 0; ai < 2; ++ai)
#pragma unroll
            for (int m = 0; m < 4; ++m) {
                const int r = u.pm * BM + ai * HALF + wr * 64 + m * 16 + fr; float ss = 0.f;
#pragma unroll
                for (int bj = 0; bj < 2; ++bj)
#pragma unroll
                    for (int n = 0; n < 2; ++n) {
                        const size_t of = (size_t)r * DM + u.pn * 256 + bj * HALF + wc * 32 + 8 * fq + 4 * n;
                        const f32x4 a = acc[ai][bj][m][n], p = unpack4(*(const u32x2*)(pb + of)); f32x4 x = *(const f32x4*)(x2 + of);
#pragma unroll
                        for (int j = 0; j < 4; ++j) x[j] += sigmoidf_(a[j]) * p[j];
                        *(f32x4*)(o + of) = x; ss += x[0] * x[0] + x[1] * x[1] + x[2] * x[2] + x[3] * x[3];
                    }
                ss += __shfl_xor(ss, 16); ss += __shfl_xor(ss, 32);
                if (fq == 0) ssq[((size_t)u.pn * MTOK + r) * 4 + wc] = ss;
            }
    }
};

__device__ __forceinline__ void conv_t(LAS float* tile, const float* __restrict__ src, int K, int N, bf16_t* dst, int gap_at, int gap) {
    const int tid = threadIdx.x, nNt = (N + 127) >> 7, ntile = (K >> 6) * nNt;
    for (int t = blockIdx.x; t < ntile; t += gridDim.x) {
        const int k0 = (t / nNt) << 6, n0 = (t % nNt) << 7;
        const int row = tid >> 5, c4 = (tid & 31) << 2, n = n0 + c4;
        f32x4 v[4];
#pragma unroll
        for (int rr = 0; rr < 4; ++rr) { v[rr] = (f32x4){0.f, 0.f, 0.f, 0.f}; if (n < N) v[rr] = *(const f32x4*)(src + (size_t)(k0 + row + rr * 16) * N + n); }
#pragma unroll
        for (int rr = 0; rr < 4; ++rr)
#pragma unroll
            for (int i = 0; i < 4; ++i) tile[(row + rr * 16) * 129 + c4 + i] = v[rr][i];
        __syncthreads();
        const int kk = (tid & 7) << 3;
#pragma unroll
        for (int h = 0; h < 2; ++h) { const int nn = (tid >> 3) + h * 64, nq = n0 + nn;
            if (nq < N) {
                const int np = nq + (nq >= gap_at ? gap : 0); u32x4 w;
                w.x = cvt_pk_bf16(tile[(kk + 0) * 129 + nn], tile[(kk + 1) * 129 + nn]); w.y = cvt_pk_bf16(tile[(kk + 2) * 129 + nn], tile[(kk + 3) * 129 + nn]);
                w.z = cvt_pk_bf16(tile[(kk + 4) * 129 + nn], tile[(kk + 5) * 129 + nn]); w.w = cvt_pk_bf16(tile[(kk + 6) * 129 + nn], tile[(kk + 7) * 129 + nn]);
                *(u32x4*)(dst + (size_t)np * K + k0 + kk) = w;
            } }
        __syncthreads();
    }
}

struct ConvJob { const float* src; bf16_t* dst; int K, N, nNt, ntile; };
__device__ __forceinline__ void conv_wave_load(const ConvJob& J, int t, int lane, f32x4 (&v)[8]) {
    const int k0 = (t / J.nNt) << 6, n0 = (t % J.nNt) << 5;
    const float* p = J.src + (size_t)(k0 + (lane >> 3)) * J.N + n0 + ((lane & 7) << 2);
#pragma unroll
    for (int i = 0; i < 8; ++i) v[i] = *(const f32x4*)(p + (size_t)(i * 8) * J.N);
}
__device__ __forceinline__ void conv_wave_store(const ConvJob& J, int t, int lane, const f32x4 (&v)[8], LAS float* tile) {
    const int k0 = (t / J.nNt) << 6, n0 = (t % J.nNt) << 5;
#pragma unroll
    for (int i = 0; i < 8; ++i) *(LAS f32x4*)(tile + ((lane >> 3) + i * 8) * 36 + ((lane & 7) << 2)) = v[i];
    const int nn = lane >> 1, kh = (lane & 1) << 5;
    u32x4 w[4];
#pragma unroll
    for (int j = 0; j < 4; ++j) { const LAS float* tp = tile + (kh + j * 8) * 36 + nn;
        w[j].x = cvt_pk_bf16(tp[0], tp[36]); w[j].y = cvt_pk_bf16(tp[72], tp[108]); w[j].z = cvt_pk_bf16(tp[144], tp[180]); w[j].w = cvt_pk_bf16(tp[216], tp[252]); }
    bf16_t* d = J.dst + (size_t)(n0 + nn) * J.K + k0 + kh;
#pragma unroll
    for (int j = 0; j < 4; ++j) *(u32x4*)(d + j * 8) = w[j];
}
__device__ __forceinline__ void conv_wave_run(const ConvJob& J, int slot, int nslots, int lane, LAS float* tile) {
    f32x4 v[8];
    for (int t = slot; t < J.ntile; t += nslots) { conv_wave_load(J, t, lane, v); conv_wave_store(J, t, lane, v, tile); }
}
__device__ __forceinline__ void phase0(PP P, LAS unsigned char* lds) {
    char* ws = P->ws; const int tid = threadIdx.x, lane = tid & 63, wid = tid >> 6;
    const size_t gtid = (size_t)blockIdx.x * 512 + tid, gsz = (size_t)gridDim.x * 512;
    LAS float* tile = (LAS float*)lds;
    conv_t(tile, P->in[9], 2048, 8992, (bf16_t*)(ws + WT_IN), 4896, 224);
    { u32x4* z = (u32x4*)(ws + WT_IN + (size_t)4896 * 2048 * 2); for (size_t i = gtid; i < (size_t)224 * 2048 * 2 / 16; i += gsz) z[i] = (u32x4){0u, 0u, 0u, 0u}; }
    { const float* gm = P->in[8]; bf16_t* h = (bf16_t*)(ws + HBUF);
      for (int r = blockIdx.x * 8 + wid; r < MTOK; r += gridDim.x * 8) {
          const float* x = r < MPR ? P->in[0] + (size_t)r * DM : P->in[1] + (size_t)(r - MPR) * DM; f32x4 v[8]; float ss = 0.f;
#pragma unroll
          for (int i = 0; i < 8; ++i) { v[i] = *(const f32x4*)(x + i * 256 + lane * 4); ss += v[i][0] * v[i][0] + v[i][1] * v[i][1] + v[i][2] * v[i][2] + v[i][3] * v[i][3]; }
          ss = wave_sum(ss); const float rs = rsqrtf(ss * (1.0f / 2048.0f) + 1e-6f);
#pragma unroll
          for (int i = 0; i < 8; ++i) { const f32x4 g = *(const f32x4*)(gm + i * 256 + lane * 4); *(u32x2*)(h + (size_t)r * DM + i * 256 + lane * 4) = pack4(v[i] * rs * g); }
      } }
}

__device__ __forceinline__ void phase0_late(PP P, int bidx, int nblk) {
    char* ws = P->ws; const int tid = threadIdx.x;
    const size_t gtid = (size_t)bidx * 512 + tid, gsz = (size_t)nblk * 512;
    { bf16_t* L = (bf16_t*)(ws + WT_LORA); const float *w2 = P->in[13], *a2 = P->in[15], *g2 = P->in[16];
      for (size_t i = gtid; i < (size_t)3072 * 384; i += gsz) { const int n = (int)(i / 384), k = (int)(i % 384); float v = 0.f;
          if (n < 1024) { if (k < 64) v = w2[k * 1024 + n]; } else if (n < 2048) { if (k >= 64 && k < 128) v = a2[(k - 64) * 1024 + n - 1024]; } else { if (k >= 128 && k < 288) v = g2[(k - 128) * 1024 + n - 2048]; }
          L[i] = (bf16_t)(cvt_pk_bf16(v, 0.f) & 0xffffu); } }
    { bf16_t* pb = (bf16_t*)(ws + PEB);
      for (size_t i = gtid; i < (size_t)MTOK * 64; i += gsz) { const size_t e = i * 4; const float* s = e < (size_t)MPR * 256 ? P->in[6] + e : P->in[7] + (e - (size_t)MPR * 256); *(u32x2*)(pb + e) = pack4(*(const f32x4*)s); } }
    { bf16_t *ks = (bf16_t*)(ws + KS), *vs = (bf16_t*)(ws + VS);
      for (size_t i = gtid; i < (size_t)32 * 144 * 64; i += gsz) { const int b = (int)(i / (144 * 64)), rem = (int)(i % (144 * 64)), key = rem >> 6, c = (rem & 63) << 2;
          if (key >= 128 && key < 136) continue;
          f32x4 kv = (f32x4){0.f, 0.f, 0.f, 0.f}, vv = kv;
          if (key < 128) { kv = *(const f32x4*)(P->in[2] + ((size_t)b * 128 + key) * 256 + c); vv = *(const f32x4*)(P->in[3] + ((size_t)b * 128 + key) * 256 + c);
              if (key >= 8) { *(f32x4*)(P->out + O_KWS + ((size_t)b * 128 + key - 8) * 256 + c) = kv; *(f32x4*)(P->out + O_VWS + ((size_t)b * 128 + key - 8) * 256 + c) = vv; } }
          *(u32x2*)(ks + ((size_t)b * 144 + key) * 256 + c) = pack4(kv); *(u32x2*)(vs + ((size_t)b * 144 + key) * 256 + c) = pack4(vv); } }
}

constexpr int VT_STRIDE = 168, VT_BYTES = 64 * VT_STRIDE * 2;
__device__ __forceinline__ void attn_job(PP P, LAS bf16_t* vt, int job, int lane) {
    char* ws = P->ws; const int fr = lane & 15, fq = lane >> 4;
    const bool smp = job >= 2048; int b, kvh, q0;
    if (!smp) { const int qt = job >> 2; kvh = job & 3; b = qt >> 8; q0 = (qt & 255) << 4; } else { const int js = job - 2048; b = js >> 2; kvh = js & 3; q0 = 128; }
    const bf16_t* kbase = smp ? (const bf16_t*)(ws + KS) + (size_t)b * 144 * 256 : (const bf16_t*)(ws + KP) + ((size_t)b * 4096 + q0 - 128) * 256;
    const bf16_t* vbase = smp ? (const bf16_t*)(ws + VS) + (size_t)b * 144 * 256 : (const bf16_t*)(ws + VP) + ((size_t)b * 4096 + q0 - 128) * 256;
    const int jmin = smp ? 0 : (128 - q0 > 0 ? 128 - q0 : 0);
    for (int i = lane; i < 160 * 8; i += 64) { const int j = i >> 3, c8 = i & 7; u32x4 w = (u32x4){0u, 0u, 0u, 0u};
        if (j >= jmin && j < 144) w = *(const u32x4*)(vbase + (size_t)j * 256 + kvh * 64 + c8 * 8);
        LAS bf16_t* d = vt + (c8 * 8) * VT_STRIDE + j;
        d[0] = (bf16_t)(w.x & 0xffff); d[VT_STRIDE] = (bf16_t)(w.x >> 16); d[2 * VT_STRIDE] = (bf16_t)(w.y & 0xffff); d[3 * VT_STRIDE] = (bf16_t)(w.y >> 16);
        d[4 * VT_STRIDE] = (bf16_t)(w.z & 0xffff); d[5 * VT_STRIDE] = (bf16_t)(w.z >> 16); d[6 * VT_STRIDE] = (bf16_t)(w.w & 0xffff); d[7 * VT_STRIDE] = (bf16_t)(w.w >> 16); }
    const bf16_t* qrow = (const bf16_t*)(ws + QB) + (smp ? (size_t)(MPR + b * 8 + (fr & 7)) : (size_t)(b * 4096 + q0 + fr)) * 1024;
    bf16_t* orow = (bf16_t*)(ws + YA) + (smp ? (size_t)(MPR + b * 8 + (fr & 7)) : (size_t)(b * 4096 + q0 + fr)) * 1024;
    for (int g = 0; g < 4; ++g) {
        const int hd = kvh * 4 + g; const float slope = exp2f(-0.5f * (float)(hd + 1)), sink = P->in[10][hd];
        const bf16x8 q0f = *(const bf16x8*)(qrow + hd * 64 + fq * 8), q1f = *(const bf16x8*)(qrow + hd * 64 + 32 + fq * 8);
        f32x4 s[9]; float mx = -1e30f;
#pragma unroll
        for (int kt = 0; kt < 9; ++kt) {
            if (kt % 3 == 0) asm volatile("" ::: "memory");
            bf16x8 k0f = (bf16x8){0, 0, 0, 0, 0, 0, 0, 0}, k1f = k0f;
            { const int jk = kt * 16 + fr; if (jk >= jmin) { const bf16_t* kp_ = kbase + (size_t)jk * 256 + kvh * 64 + fq * 8; k0f = *(const bf16x8*)kp_; k1f = *(const bf16x8*)(kp_ + 32); } }
            f32x4 a = __builtin_amdgcn_mfma_f32_16x16x32_bf16(k0f, q0f, (f32x4){0.f, 0.f, 0.f, 0.f}, 0, 0, 0);
            a = __builtin_amdgcn_mfma_f32_16x16x32_bf16(k1f, q1f, a, 0, 0, 0);
#pragma unroll
            for (int j = 0; j < 4; ++j) { const int jp = kt * 16 + fq * 4 + j, dist = 128 + fr - jp; const bool ok = dist >= 0 && dist <= 128 && jp >= jmin;
                a[j] = ok ? a[j] * 0.125f - slope * (float)dist : -1e30f; mx = fmaxf(mx, a[j]); }
            s[kt] = a;
        }
        mx = fmaxf(mx, __shfl_xor(mx, 16)); mx = fmaxf(mx, __shfl_xor(mx, 32));
        const float mm = fmaxf(mx, sink); float sum = 0.f;
#pragma unroll
        for (int kt = 0; kt < 9; ++kt)
#pragma unroll
            for (int j = 0; j < 4; ++j) { const float p = s[kt][j] > -1e29f ? __expf(s[kt][j] - mm) : 0.f; s[kt][j] = p; sum += p; }
        sum += __shfl_xor(sum, 16); sum += __shfl_xor(sum, 32);
        const float inv = 1.0f / (sum + __expf(sink - mm));
        f32x4 o[4];
#pragma unroll
        for (int dt = 0; dt < 4; ++dt) o[dt] = (f32x4){0.f, 0.f, 0.f, 0.f};
#pragma unroll
        for (int pp = 0; pp < 5; ++pp) {
            const f32x4 p0 = s[2 * pp] * inv; f32x4 p1 = (f32x4){0.f, 0.f, 0.f, 0.f}; if (pp < 4) p1 = s[2 * pp + 1] * inv;
            u32x4 pw; pw.x = cvt_pk_bf16(p0[0], p0[1]); pw.y = cvt_pk_bf16(p0[2], p0[3]); pw.z = cvt_pk_bf16(p1[0], p1[1]); pw.w = cvt_pk_bf16(p1[2], p1[3]);
            const bf16x8 pb = __builtin_bit_cast(bf16x8, pw);
#pragma unroll
            for (int dt = 0; dt < 4; ++dt) {
                const LAS bf16_t* vp = vt + (dt * 16 + fr) * VT_STRIDE + pp * 32 + fq * 4;
                u32x4 vw; const u32x2 lo = *(const LAS u32x2*)vp, hi = *(const LAS u32x2*)(vp + 16); vw.x = lo.x; vw.y = lo.y; vw.z = hi.x; vw.w = hi.y;
                o[dt] = __builtin_amdgcn_mfma_f32_16x16x32_bf16(__builtin_bit_cast(bf16x8, vw), pb, o[dt], 0, 0, 0);
            }
        }
        if (!smp || fr < 8) {
#pragma unroll
            for (int dt = 0; dt < 4; ++dt) *(u32x2*)(orow + hd * 64 + dt * 16 + fq * 4) = pack4(o[dt]);
        }
    }
}

__device__ __forceinline__ float xx_col(PP P, const bf16_t* cols, int r, int col) {
    const float c = bf2f(cols[(size_t)r * RCL + col]); float p;
    if (r < MPR) p = (r & 4095) == 0 ? 0.f : bf2f(cols[(size_t)(r - 1) * RCL + col]);
    else { const int rs = r - MPR; p = (rs & 7) == 0 ? P->in[5][(size_t)(rs >> 3) * RC + col] : bf2f(cols[(size_t)(r - 1) * RCL + col]); }
    return c + (p - c) * P->in[11][col];
}
__device__ __forceinline__ void lora_a_phase(PP P) {
    const bf16_t* cols = (const bf16_t*)((const char*)P->out + O_COLS); bf16_t* A = (bf16_t*)((char*)P->out + O_LORA_A);
    const size_t gtid = (size_t)blockIdx.x * 512 + threadIdx.x, gsz = (size_t)gridDim.x * 512;
    for (size_t i = gtid; i < (size_t)MTOK * 96; i += gsz) { const int r = (int)(i / 96), j4 = (int)(i % 96) * 4; f32x4 v = (f32x4){0.f, 0.f, 0.f, 0.f};
        if (j4 < 288) {
#pragma unroll
            for (int j = 0; j < 4; ++j) { const float x = xx_col(P, cols, r, 3072 + j4 + j); v[j] = j4 < 64 ? tanhf(x) : (j4 < 128 ? x : sigmoidf_(x)); } }
        *(u32x2*)(A + (size_t)r * 384 + j4) = pack4(v); }
}
__device__ __forceinline__ f32x4 ld4bf(const bf16_t* p) { return unpack4(*(const u32x2*)p); }
__device__ __forceinline__ f32x4 xx4(PP P, const bf16_t* cols, int r, int col) {
    const f32x4 c = ld4bf(cols + (size_t)r * RCL + col); f32x4 p = (f32x4){0.f, 0.f, 0.f, 0.f};
    if (r < MPR) { if ((r & 4095) != 0) p = ld4bf(cols + (size_t)(r - 1) * RCL + col); }
    else { const int rs = r - MPR; if ((rs & 7) == 0) p = *(const f32x4*)(P->in[5] + (size_t)(rs >> 3) * RC + col); else p = ld4bf(cols + (size_t)(r - 1) * RCL + col); }
    return c + (p - c) * *(const f32x4*)(P->in[11] + col);
}
__device__ __forceinline__ float quad_sum(float x) { x = DPP_ADD(x, 0xB1); x = DPP_ADD(x, 0x4E); return x; }
__device__ __forceinline__ float hsum4(f32x4 v) { return (v[0] + v[1]) + (v[2] + v[3]); }
__device__ __forceinline__ void prep_token(PP P, int r, int lane, float* rec0, size_t hstride) {
    const bf16_t* cols = (const bf16_t*)((const char*)P->out + O_COLS); const bf16_t* lo = (const bf16_t*)(P->ws + LORA_OUT) + (size_t)r * 3072;
    const int hd = lane >> 2, sub = lane & 3, ch0 = lane * 16;
    float ss = 0.f, bon = 0.f;
#pragma unroll 1
    for (int q = 0; q < 4; ++q) { const int c = ch0 + q * 4;
        const f32x4 xr = xx4(P, cols, r, c), xk = xx4(P, cols, r, 1024 + c), a = ld4bf(lo + 1024 + c);
        const f32x4 kk = xk * *(const f32x4*)(P->in[17] + c); ss += hsum4(kk * kk);
        const f32x4 k32 = xk * (1.0f + (a - 1.0f) * *(const f32x4*)(P->in[18] + c));
        bon += hsum4(xr * k32 * *(const f32x4*)(P->in[19] + c)); }
    ss = quad_sum(ss); bon = quad_sum(bon);
    const float inv = rsqrtf(fmaxf(ss, 1e-24f));
    if (sub == 0) ((float*)(P->ws + BON))[(size_t)r * 32 + hd] = bon;
    float* rec = rec0 + (size_t)hd * hstride + sub * 16;
#pragma unroll 1
    for (int q = 0; q < 4; ++q) { const int c = ch0 + q * 4;
        const f32x4 xr = xx4(P, cols, r, c), xk = xx4(P, cols, r, 1024 + c), xv = xx4(P, cols, r, 2048 + c), e = ld4bf(lo + c), a = ld4bf(lo + 1024 + c);
        const f32x4 kn = xk * *(const f32x4*)(P->in[17] + c) * inv;
        const f32x4 k32 = xk * (1.0f + (a - 1.0f) * *(const f32x4*)(P->in[18] + c));
        f32x4 w;
#pragma unroll
        for (int j = 0; j < 4; ++j) w[j] = __expf(-e[j]);
        *(f32x4*)(rec + q * 4) = -kn; *(f32x4*)(rec + 64 + q * 4) = w; *(f32x4*)(rec + 128 + q * 4) = kn * a;
        *(f32x4*)(rec + 192 + q * 4) = k32; *(f32x4*)(rec + 256 + q * 4) = xr; *(f32x4*)(rec + 320 + q * 4) = xv; }
}
__device__ __forceinline__ void post_token(PP P, int r, int lane, const f32x4 (&y)[4]) {
    const bf16_t* cols = (const bf16_t*)((const char*)P->out + O_COLS); const bf16_t* lo = (const bf16_t*)(P->ws + LORA_OUT) + (size_t)r * 3072;
    const int hd = lane >> 2, ch0 = lane * 16;
    const float mean = quad_sum(hsum4(y[0]) + hsum4(y[1]) + hsum4(y[2]) + hsum4(y[3])) * (1.0f / 64.0f);
    float vs = 0.f;
#pragma unroll
    for (int q = 0; q < 4; ++q) { const f32x4 d = y[q] - mean; vs += hsum4(d * d); }
    const float rstd = rsqrtf(quad_sum(vs) * (1.0f / 64.0f) + 64e-5f), bon = ((const float*)(P->ws + BON))[(size_t)r * 32 + hd];
#pragma unroll
    for (int q = 0; q < 4; ++q) { const int c = ch0 + q * 4;
        f32x4 yn = (y[q] - mean) * rstd * *(const f32x4*)(P->in[20] + c) + *(const f32x4*)(P->in[21] + c);
        yn += bon * xx4(P, cols, r, 2048 + c);
        *(u32x2*)((bf16_t*)(P->ws + YR) + (size_t)r * 1024 + c) = pack4(yn * ld4bf(lo + 2048 + c)); }
}
struct StepOps { f32x4 nk, w, ka, k, r; float vv; };
__device__ __forceinline__ float wkv_step(f32x4& S, const StepOps& o) {
    f32x2 s01 = {S[0], S[1]}, s23 = {S[2], S[3]};
    f32x2 t = s01 * (f32x2){o.nk[0], o.nk[1]}; t = __builtin_elementwise_fma(s23, (f32x2){o.nk[2], o.nk[3]}, t);
    const float sa = row16_sum(t[0] + t[1]);
    const f32x2 sa2 = {sa, sa}, vv2 = {o.vv, o.vv};
    f32x2 u01 = (f32x2){o.k[0], o.k[1]} * vv2, u23 = (f32x2){o.k[2], o.k[3]} * vv2;
    u01 = __builtin_elementwise_fma((f32x2){o.ka[0], o.ka[1]}, sa2, u01); u23 = __builtin_elementwise_fma((f32x2){o.ka[2], o.ka[3]}, sa2, u23);
    s01 = __builtin_elementwise_fma(s01, (f32x2){o.w[0], o.w[1]}, u01); s23 = __builtin_elementwise_fma(s23, (f32x2){o.w[2], o.w[3]}, u23);
    S = (f32x4){s01[0], s01[1], s23[0], s23[1]};
    f32x2 y = s01 * (f32x2){o.r[0], o.r[1]}; y = __builtin_elementwise_fma(s23, (f32x2){o.r[2], o.r[3]}, y);
    return y[0] + y[1];
}
__device__ __forceinline__ void lds_step(StepOps& o, const LAS float* rp, int li, int row) {
    o.nk = *(const LAS f32x4*)(rp + li * 4); o.w = *(const LAS f32x4*)(rp + 64 + li * 4); o.ka = *(const LAS f32x4*)(rp + 128 + li * 4);
    o.k = *(const LAS f32x4*)(rp + 192 + li * 4); o.r = *(const LAS f32x4*)(rp + 256 + li * 4); o.vv = rp[320 + row];
}
__device__ __forceinline__ void scan_issue(const float* recs, LAS unsigned char* lb, int c, int lane) {
    const char* gp = (const char*)recs + (size_t)c * 12288 + lane * 16; LAS unsigned char* lp = lb + (c & 3) * 12288;
#pragma unroll
    for (int g = 0; g < 3; ++g) {
        __builtin_amdgcn_global_load_lds((const unsigned*)(gp + g * 4096), (LAS unsigned*)(lp + g * 4096), 16, 0, 0);
        __builtin_amdgcn_global_load_lds((const unsigned*)(gp + g * 4096), (LAS unsigned*)(lp + g * 4096), 16, 1024, 0);
        __builtin_amdgcn_global_load_lds((const unsigned*)(gp + g * 4096), (LAS unsigned*)(lp + g * 4096), 16, 2048, 0);
        __builtin_amdgcn_global_load_lds((const unsigned*)(gp + g * 4096), (LAS unsigned*)(lp + g * 4096), 16, 3072, 0);
    }
}
__device__ __forceinline__ void scan_seg(const float* recs, LAS float* lbf, f32x4& S, float* yout, int row, int ycol, int lane) {
    const int li = lane & 15; LAS unsigned char* lb = (LAS unsigned char*)lbf;
    scan_issue(recs, lb, 0, lane); scan_issue(recs, lb, 1, lane); scan_issue(recs, lb, 2, lane);
    asm volatile("s_waitcnt vmcnt(24)" ::: "memory");
    StepOps cur, n1, n2; lds_step(cur, lbf, li, row); lds_step(n1, lbf + 384, li, row);
#pragma unroll 12
    for (int c = 0; c < 64; ++c) {
        const LAS float* bcur = lbf + (c & 3) * 3072; const LAS float* bnxt = lbf + ((c + 1) & 3) * 3072;
        float yp[8];
#pragma unroll
        for (int tt = 0; tt < 8; ++tt) {
            if (tt == 1 && c + 3 < 64) scan_issue(recs, lb, c + 3, lane);
            if (tt == 5) { if (c < 61) asm volatile("s_waitcnt vmcnt(24)" ::: "memory"); else if (c == 61) asm volatile("s_waitcnt vmcnt(12)" ::: "memory"); else asm volatile("s_waitcnt vmcnt(0)" ::: "memory"); }
            if (tt < 6) lds_step(n2, bcur + (tt + 2) * 384, li, row);
            else if (c < 63) lds_step(n2, bnxt + (tt - 6) * 384, li, row);
            yp[tt] = wkv_step(S, cur);
            cur = n1; n1 = n2;
        }
        { const bool b0 = (li & 1) != 0; float q[4];
#pragma unroll
          for (int j = 0; j < 4; ++j) { const float keep = b0 ? yp[2 * j + 1] : yp[2 * j], send = b0 ? yp[2 * j] : yp[2 * j + 1]; q[j] = keep + DPPX(send, 0xB1); }
#pragma unroll
          for (int j = 0; j < 4; ++j) q[j] = q[j] + DPPX(q[j], 0x4E);
#pragma unroll
          for (int j = 0; j < 4; ++j) q[j] = q[j] + DPPX(q[j], 0x124);
#pragma unroll
          for (int j = 0; j < 4; ++j) q[j] = q[j] + DPPX(q[j], 0x128);
          const int jj = (li >> 1) & 3; const float ysel = jj == 0 ? q[0] : (jj == 1 ? q[1] : (jj == 2 ? q[2] : q[3]));
          if (li < 8) yout[(size_t)(c * 8 + li) * 8 + ycol] = ysel; }
    }
}
__device__ __forceinline__ void scan_sample_job(PP P, int q, int lane) {
    const int bh = q >> 4, row = (q & 15) * 4 + (lane >> 4), li = lane & 15;
    f32x4 S = *(const f32x4*)(P->in[4] + ((size_t)bh * 64 + row) * 64 + li * 4);
    const float* rec = (const float*)(P->ws + SREC) + (size_t)bh * 8 * 384; float* yo = (float*)(P->ws + YRAW_S);
    float ysel = 0.f;
#pragma unroll
    for (int hb = 0; hb < 2; ++hb) {
        StepOps o[4];
#pragma unroll
        for (int t = 0; t < 4; ++t) { const float* rp = rec + (hb * 4 + t) * 384;
            o[t].nk = *(const f32x4*)(rp + li * 4); o[t].w = *(const f32x4*)(rp + 64 + li * 4); o[t].ka = *(const f32x4*)(rp + 128 + li * 4);
            o[t].k = *(const f32x4*)(rp + 192 + li * 4); o[t].r = *(const f32x4*)(rp + 256 + li * 4); o[t].vv = rp[320 + row]; }
#pragma unroll
        for (int t = 0; t < 4; ++t) { const float y = row16_sum(wkv_step(S, o[t])); ysel = (li == hb * 4 + t) ? y : ysel; }
    }
    if (li < 8) yo[((size_t)q * 8 + li) * 4 + (lane >> 4)] = ysel;
    *(f32x4*)(P->out + O_WKVS + ((size_t)bh * 64 + row) * 64 + li * 4) = S;
}

#define XB_TMO      128
#define XB_XCNT(j)  (256  + 64 * (j))
#define XB_XSUB(j)  (1280 + 64 * (j))
#define XB_XGEN(j)  (2304 + 64 * (j))
#define XB_TOP      3328
#define XB_TOPGEN   3392
#define XCD_BAR_WORDS 3456
#define XB_SPIN_CAP (1u << 18)
__device__ __forceinline__ unsigned xb_ld(unsigned* p)              { return __hip_atomic_load(p, __ATOMIC_RELAXED, __HIP_MEMORY_SCOPE_AGENT); }
__device__ __forceinline__ unsigned xb_add(unsigned* p, unsigned v) { return __hip_atomic_fetch_add(p, v, __ATOMIC_RELAXED, __HIP_MEMORY_SCOPE_AGENT); }
__device__ __forceinline__ unsigned xb_xcc_id() { return (unsigned)__builtin_amdgcn_s_getreg((3 << 11) | 20) & 0xFu; }
#define XB_SPIN(cond, bar) do { unsigned _sp = 0; while (cond) { __builtin_amdgcn_s_sleep(1); \
    if ((++_sp & 255u) == 0u) { if (xb_ld(&(bar)[XB_TMO])) break; if (_sp > XB_SPIN_CAP) { atomicAdd(&(bar)[XB_TMO], 1u); break; } } } } while (0)
struct XcdBarrier { unsigned* bar; unsigned x; volatile LAS unsigned* st; };
__device__ __forceinline__ XcdBarrier xcd_barrier_post(unsigned* bar, volatile LAS unsigned* st) {
    XcdBarrier b; b.bar = bar; b.x = xb_xcc_id(); b.st = st;
    if (threadIdx.x == 0) (void)xb_add(&bar[XB_XCNT(b.x)], 1u);
    return b;
}
__device__ __forceinline__ void xcd_barrier_complete(unsigned* bar, unsigned x, unsigned& nloc, unsigned& nx) {
    const unsigned G = gridDim.x * gridDim.y * gridDim.z;
    unsigned sum, cnt, mine, sp = 0u;
    for (;;) {
        sum = 0u; cnt = 0u; mine = 0u;
#pragma unroll
        for (unsigned j = 0; j < 16; ++j) { const unsigned c = xb_ld(&bar[XB_XCNT(j)]); sum += c; cnt += (c > 0u) ? 1u : 0u; mine = (j == x) ? c : mine; }
        if (sum == G) break;
        __builtin_amdgcn_s_sleep(1);
        if ((++sp & 255u) == 0u) { if (xb_ld(&bar[XB_TMO])) break; if (sp > XB_SPIN_CAP) { atomicAdd(&bar[XB_TMO], 1u); break; } }
    }
    nloc = mine > 0u ? mine : 1u; nx = cnt > 0u ? cnt : 1u;
}
__device__ __forceinline__ void xcd_barrier(const XcdBarrier& b) {
    asm volatile("s_waitcnt vmcnt(0)" ::: "memory");
    __syncthreads();
    if (threadIdx.x == 0) {
        unsigned* bar = b.bar;
        __builtin_amdgcn_s_waitcnt(0);
        unsigned nloc = b.st[0], nx = b.st[1];
        if (nloc == 0u) { xcd_barrier_complete(bar, b.x, nloc, nx); b.st[0] = nloc; b.st[1] = nx; }
        const unsigned old = xb_add(&bar[XB_XSUB(b.x)], 1u);
        const unsigned gen = old / nloc;
        if (old + 1u == (gen + 1u) * nloc) {
            __builtin_amdgcn_fence(__ATOMIC_RELEASE, "agent");
            asm volatile("s_waitcnt vmcnt(0)" ::: "memory");
            const unsigned og = xb_add(&bar[XB_TOP], 1u);
            const unsigned tg = og / nx;
            if (og + 1u == (tg + 1u) * nx) xb_add(&bar[XB_TOPGEN], 1u);
            else XB_SPIN(xb_ld(&bar[XB_TOPGEN]) == tg, bar);
            __builtin_amdgcn_fence(__ATOMIC_ACQUIRE, "agent");
            xb_add(&bar[XB_XGEN(b.x)], 1u);
            asm volatile("s_waitcnt vmcnt(0)" ::: "memory");
        } else {
            XB_SPIN(xb_ld(&bar[XB_XGEN(b.x)]) == gen, bar);
            __builtin_amdgcn_fence(__ATOMIC_ACQUIRE, "agent");
            asm volatile("s_waitcnt vmcnt(0)" ::: "memory");
        }
    }
    __syncthreads();
}
__device__ __forceinline__ f32x4 part_sum(const float* part, int s0, int ns, int rl, int c) {
    f32x4 a = *(const f32x4*)(part + ((size_t)s0 * 256 + rl) * DM + c);
    for (int s = 1; s < ns; ++s) a += *(const f32x4*)(part + ((size_t)(s0 + s) * 256 + rl) * DM + c);
    return a;
}
__device__ __forceinline__ void ssq_store(float* ssq, const f32x4 x, int r, int t) {
    const float ss = row16_sum(x[0] * x[0] + x[1] * x[1] + x[2] * x[2] + x[3] * x[3]);
    if ((t & 15) == 0) ssq[((size_t)(t >> 6) * MTOK + r) * 4 + ((t & 63) >> 4)] = ss;
}
#define CG_SYNC() do { asm volatile("s_waitcnt vmcnt(0) lgkmcnt(0)" ::: "memory"); grid.sync(); \
    __builtin_amdgcn_fence(__ATOMIC_ACQUIRE, "agent"); asm volatile("s_waitcnt vmcnt(0)" ::: "memory"); } while (0)
#define GRID_SYNC() xcd_barrier(xbar)
__global__ void __launch_bounds__(512) fwd_megakernel(Params Pk) {
    extern __shared__ __attribute__((aligned(16))) unsigned char smem_raw[];
    LAS unsigned char* lds = (LAS unsigned char*)smem_raw;
    cg::grid_group grid = cg::this_grid();
    volatile LAS unsigned* xst = (volatile LAS unsigned*)(lds + 131072);
    if (threadIdx.x == 0) { xst[0] = 0u; xst[1] = 0u; }
    __syncthreads();
    const XcdBarrier xbar = xcd_barrier_post((unsigned*)(fresh_params()->ws + XBAR), xst);
#if (PHMASK >> 0) & 1
    { PP P = fresh_params(); char* ws = P->ws; const int tid = threadIdx.x, lane = tid & 63, wid = __builtin_amdgcn_readfirstlane(tid >> 6); Sched S; (void)lane; (void)wid; (void)S; (void)ws;
    phase0(P, lds);
    if (P->out == nullptr) CG_SYNC();
    }
    GRID_SYNC();
#endif
#ifdef DUMP_OFF
    if (DUMP_AT == 1) { PP P = fresh_params(); const bf16_t* src = (const bf16_t*)(P->ws + DUMP_OFF); float* o = P->out + 16000000;
        for (size_t i = (size_t)blockIdx.x * 512 + threadIdx.x; i < DUMP_N; i += (size_t)gridDim.x * 512) o[i] = DUMP_F32 == 2 ? ((const float*)src)[(i >> 6) * 384 + DUMP_STRIDE * 64 + (i & 63)] : DUMP_F32 ? ((const float*)src)[i * DUMP_STRIDE] : bf2f(src[i * DUMP_STRIDE]);
        return; }
#endif
#if (PHMASK >> 1) & 1
    { PP P = fresh_params(); char* ws = P->ws; const int tid = threadIdx.x, lane = tid & 63, wid = __builtin_amdgcn_readfirstlane(tid >> 6); Sched S; (void)lane; (void)wid; (void)S; (void)ws;
    { S.init(MTOK, 9216, 2048, ws + HBUF, ws + WT_IN);
      EpiIn E{(bf16_t*)(ws + QB), (bf16_t*)(ws + KP), (bf16_t*)(ws + VP), (bf16_t*)(ws + KS), (bf16_t*)(ws + VS), (bf16_t*)((char*)P->out + O_COLS), (bf16_t*)(ws + GA), (bf16_t*)(ws + GR), P->out};
      gemm_phase(lds, opaque(2048), S, E);
      const int G_ = (int)gridDim.x, nfull = S.nwg % G_;
      if (nfull > 0) { if ((int)blockIdx.x >= nfull) phase0_late(P, blockIdx.x - nfull, G_ - nfull); }
      else phase0_late(P, blockIdx.x, G_); }
    }
    GRID_SYNC();
#endif
#ifdef DUMP_OFF
    if (DUMP_AT == 2) { PP P = fresh_params(); const bf16_t* src = (const bf16_t*)(P->ws + DUMP_OFF); float* o = P->out + 16000000;
        for (size_t i = (size_t)blockIdx.x * 512 + threadIdx.x; i < DUMP_N; i += (size_t)gridDim.x * 512) o[i] = DUMP_F32 == 2 ? ((const float*)src)[(i >> 6) * 384 + DUMP_STRIDE * 64 + (i & 63)] : DUMP_F32 ? ((const float*)src)[i * DUMP_STRIDE] : bf2f(src[i * DUMP_STRIDE]);
        return; }
#endif
#if (PHMASK >> 2) & 1
    { PP P = fresh_params(); char* ws = P->ws; const int tid = threadIdx.x, lane = tid & 63, wid = __builtin_amdgcn_readfirstlane(tid >> 6); Sched S; (void)lane; (void)wid; (void)S; (void)ws;
    lora_a_phase(P);
#ifndef NOATTN
    if (wid >= 2) { LAS bf16_t* vt = (LAS bf16_t*)(lds + (wid - 2) * VT_BYTES); const int npw = gridDim.x * 6;
        for (int job = blockIdx.x * 6 + (wid - 2); job < 2048 + 128; job += npw) attn_job(P, vt, job, lane); }
#endif
    }
    GRID_SYNC();
#endif
#ifdef DUMP_OFF
    if (DUMP_AT == 3) { PP P = fresh_params(); const bf16_t* src = (const bf16_t*)(P->ws + DUMP_OFF); float* o = P->out + 16000000;
        for (size_t i = (size_t)blockIdx.x * 512 + threadIdx.x; i < DUMP_N; i += (size_t)gridDim.x * 512) o[i] = DUMP_F32 == 2 ? ((const float*)src)[(i >> 6) * 384 + DUMP_STRIDE * 64 + (i & 63)] : DUMP_F32 ? ((const float*)src)[i * DUMP_STRIDE] : bf2f(src[i * DUMP_STRIDE]);
        return; }
#endif
#if (PHMASK >> 3) & 1
    { PP P = fresh_params(); char* ws = P->ws; const int tid = threadIdx.x, lane = tid & 63, wid = __builtin_amdgcn_readfirstlane(tid >> 6); Sched S; (void)lane; (void)wid; (void)S; (void)ws;
    { S.init(MTOK, 3072, 384, (char*)P->out + O_LORA_A, ws + WT_LORA);
      EpiLora E{(bf16_t*)(ws + LORA_OUT), P->in[12], P->in[14]};
      gemm_phase(lds, opaque(384), S, E); }
    }
    GRID_SYNC();
#endif
#ifdef DUMP_OFF
    if (DUMP_AT == 4) { PP P = fresh_params(); const bf16_t* src = (const bf16_t*)(P->ws + DUMP_OFF); float* o = P->out + 16000000;
        for (size_t i = (size_t)blockIdx.x * 512 + threadIdx.x; i < DUMP_N; i += (size_t)gridDim.x * 512) o[i] = DUMP_F32 == 2 ? ((const float*)src)[(i >> 6) * 384 + DUMP_STRIDE * 64 + (i & 63)] : DUMP_F32 ? ((const float*)src)[i * DUMP_STRIDE] : bf2f(src[i * DUMP_STRIDE]);
        return; }
#endif
#if (PHMASK >> 4) & 1
    { PP P = fresh_params(); char* ws = P->ws; const int tid = threadIdx.x, lane = tid & 63, wid = __builtin_amdgcn_readfirstlane(tid >> 6); Sched S; (void)lane; (void)wid; (void)S; (void)ws;
    {
        const int B = blockIdx.x, xcd = B & 7, slot = B >> 3, bh = xcd * 4 + (slot >> 3), rq8 = slot & 7, rowb = rq8 * 8 + (wid & 1) * 4 + (lane >> 4);
        const bool scanner = wid < 2 && slot < 32;
        f32x4 St = (f32x4){0.f, 0.f, 0.f, 0.f};
        const int pw = B * 4 + ((wid & 1) | ((wid & 4) >> 1)), npw = gridDim.x * 4;
        for (int s = 0; s < 10; ++s) {
            if (s == 0) {
                for (int ti = B * 8 + wid; ti < 1024 + 256; ti += (int)gridDim.x * 8) {
                    if (ti < 1024) { const int b = ti >> 9, t = ti & 511;
                        prep_token(P, b * 4096 + t, lane, (float*)(ws + SEG) + ((size_t)(b * 16) * 512 + t) * 384, (size_t)512 * 384); }
                    else { const int tj = ti - 1024, b = tj >> 3, t = tj & 7;
                        prep_token(P, MPR + tj, lane, (float*)(ws + SREC) + ((size_t)(b * 16) * 8 + t) * 384, (size_t)8 * 384); } }
            } else if (wid < 2) {
                if (scanner && s >= 1 && s <= 8) { const int j = s - 1; __builtin_amdgcn_s_setprio(3);
                    scan_seg((const float*)(ws + SEG + (size_t)(j & 1) * SEG_SZ) + (size_t)bh * 512 * 384, (LAS float*)(lds + wid * 49152), St,
                             (float*)(ws + YRAW) + (size_t)(j & 1) * 1048576 + (size_t)(bh * 8 + rq8) * 4096, rowb, (wid & 1) * 4 + (lane >> 4), lane);
                    if (s == 8) *(f32x4*)(P->out + O_WKVP + ((size_t)bh * 64 + rowb) * 64 + (lane & 15) * 4) = St; __builtin_amdgcn_s_setprio(0); }
            } else if (wid != 4 && wid != 5) {
                if (s >= 1 && s < 8) for (int ti = pw; ti < 1024; ti += npw) { const int b = ti >> 9, t = ti & 511;
                    prep_token(P, b * 4096 + s * 512 + t, lane, (float*)(ws + SEG + (size_t)(s & 1) * SEG_SZ) + ((size_t)(b * 16) * 512 + t) * 384, (size_t)512 * 384); }
                if (s == 1) for (int job = pw; job < 8192; job += npw) scan_sample_job(P, job, lane);
                if (s >= 2) { const int j = s - 2; const float* ring = (const float*)(ws + YRAW) + (size_t)(j & 1) * 1048576;
                    for (int ti = pw; ti < 1024; ti += npw) { const int b = ti >> 9, t = ti & 511, hd = lane >> 2, sub = lane & 3; f32x4 y[4];
#pragma unroll
                        for (int q = 0; q < 4; ++q) y[q] = *(const f32x4*)(ring + ((size_t)((b * 16 + hd) * 8 + sub * 2 + (q >> 1)) * 512 + t) * 8 + (q & 1) * 4);
                        post_token(P, b * 4096 + j * 512 + t, lane, y); } }
                if (s >= 2 && s <= 8) {
                    const int hidx = (wid & 1) | ((wid & 4) >> 1); LAS float* ctile = (LAS float*)(hidx < 3 ? lds + 98304 + hidx * 9216 : lds + 131104);
                    const int slot = (s - 2) * npw + pw, nslots = 7 * npw;
                    const int widx[7] = {26, 27, 24, 29, 22, 23, 28}; const size_t wdst[7] = {WT_UP, WT_DN, WT_OUT, WT_PG, WT_BA, WT_BR, WT_PP};
                    const int wk[7] = {2048, 8192, 2048, 2048, 1024, 1024, 256}, wn[7] = {8192, 2048, 2048, 2048, 2048, 2048, 2048};
#pragma unroll
                    for (int j = 0; j < 7; ++j) { ConvJob J; J.src = P->in[widx[j]]; J.dst = (bf16_t*)(ws + wdst[j]); J.K = wk[j]; J.N = wn[j]; J.nNt = wn[j] >> 5; J.ntile = (wk[j] >> 6) * J.nNt;
                        conv_wave_run(J, (slot + j * 1171) % nslots, nslots, lane, ctile); }
                }
                if (s == 2) for (int ti = pw; ti < 256; ti += npw) { const int b = ti >> 3, t = ti & 7, hd = lane >> 2, sub = lane & 3; f32x4 y[4];
#pragma unroll
                    for (int q = 0; q < 4; ++q) y[q] = *(const f32x4*)((const float*)(ws + YRAW_S) + ((size_t)((b * 16 + hd) * 16 + sub * 4 + q) * 8 + t) * 4);
                    post_token(P, MPR + ti, lane, y); }
            }
            GRID_SYNC();
        }
    }
    }
#endif
#ifdef DUMP_OFF
    if (DUMP_AT == 5) { PP P = fresh_params(); const bf16_t* src = (const bf16_t*)(P->ws + DUMP_OFF); float* o = P->out + 16000000;
        for (size_t i = (size_t)blockIdx.x * 512 + threadIdx.x; i < DUMP_N; i += (size_t)gridDim.x * 512) o[i] = DUMP_F32 == 2 ? ((const float*)src)[(i >> 6) * 384 + DUMP_STRIDE * 64 + (i & 63)] : DUMP_F32 ? ((const float*)src)[i * DUMP_STRIDE] : bf2f(src[i * DUMP_STRIDE]);
        return; }
#endif
#if (PHMASK >> 5) & 1
    { PP P = fresh_params(); char* ws = P->ws; const int tid = threadIdx.x, lane = tid & 63, wid = __builtin_amdgcn_readfirstlane(tid >> 6); Sched S; (void)lane; (void)wid; (void)S; (void)ws;
    { S.init(MTOK, 2048, 1024, ws + YA, ws + WT_BA); S.dual = 1; S.A1 = ws + YR; S.B1 = ws + WT_BR;
      EpiMix E{(const bf16_t*)(ws + GA), (const bf16_t*)(ws + GR), (bf16_t*)(ws + MIXED), P->out};
      S.set_tail(4); S.nosub = 1;
      gemm_phase(lds, opaque(1024), S, E);
      Sched S2; S2.init(MTOK, 2048, 1024, ws + YA, ws + WT_BA); S2.A1 = ws + YR; S2.B1 = ws + WT_BR; S2.set_tail(4); S2.ngem = 2; S2.tail_i = 0; S2.part = (float*)(ws + SEG);
      EpiNone E2{}; gemm_phase(lds, opaque(1024), S2, E2); }
    }
    GRID_SYNC();
    { PP P = fresh_params(); char* ws = P->ws; const int t = threadIdx.x, rl = blockIdx.x;
      if (rl < 256) { const int c = t * 4; const size_t o = (size_t)(MPR + rl) * DM + c; const float* part = (const float*)(ws + SEG);
        const f32x4 a0 = part_sum(part, 0, 4, rl, c), a1 = part_sum(part, 4, 4, rl, c);
        const f32x4 ga = unpack4(*(const u32x2*)((const bf16_t*)(ws + GA) + o)), gr = unpack4(*(const u32x2*)((const bf16_t*)(ws + GR) + o));
        *(u32x2*)((bf16_t*)(ws + MIXED) + o) = pack4(ga * a0 + gr * a1); }
    }
    GRID_SYNC();
#endif
#ifdef DUMP_OFF
    if (DUMP_AT == 6) { PP P = fresh_params(); const bf16_t* src = (const bf16_t*)(P->ws + DUMP_OFF); float* o = P->out + 16000000;
        for (size_t i = (size_t)blockIdx.x * 512 + threadIdx.x; i < DUMP_N; i += (size_t)gridDim.x * 512) o[i] = DUMP_F32 == 2 ? ((const float*)src)[(i >> 6) * 384 + DUMP_STRIDE * 64 + (i & 63)] : DUMP_F32 ? ((const float*)src)[i * DUMP_STRIDE] : bf2f(src[i * DUMP_STRIDE]);
        return; }
#endif
#if (PHMASK >> 6) & 1
    { PP P = fresh_params(); char* ws = P->ws; const int tid = threadIdx.x, lane = tid & 63, wid = __builtin_amdgcn_readfirstlane(tid >> 6); Sched S; (void)lane; (void)wid; (void)S; (void)ws;
    { S.init(MTOK, 2048, 2048, ws + MIXED, ws + WT_OUT);
      EpiOut E{P->in[0], P->in[1], P->in[25], (float*)(ws + X1), (float*)(ws + SSQ1), (bf16_t*)(ws + HN)};
      S.set_tail(8); S.part = (float*)(ws + YR);
      gemm_phase(lds, opaque(2048), S, E); }
    }
    GRID_SYNC();
    { PP P = fresh_params(); char* ws = P->ws; const int t = threadIdx.x, rl = blockIdx.x;
      if (rl < 256) { const int c = t * 4, r = MPR + rl; const size_t o = (size_t)r * DM + c;
        const f32x4 x = *(const f32x4*)(P->in[1] + (size_t)rl * DM + c) + part_sum((const float*)(ws + YR), 0, 8, rl, c);
        *(f32x4*)((float*)(ws + X1) + o) = x; *(u32x2*)((bf16_t*)(ws + HN) + o) = pack4(x * *(const f32x4*)(P->in[25] + c));
        ssq_store((float*)(ws + SSQ1), x, r, t); }
    }
    GRID_SYNC();
#endif
#ifdef DUMP_OFF
    if (DUMP_AT == 7) { PP P = fresh_params(); const bf16_t* src = (const bf16_t*)(P->ws + DUMP_OFF); float* o = P->out + 16000000;
        for (size_t i = (size_t)blockIdx.x * 512 + threadIdx.x; i < DUMP_N; i += (size_t)gridDim.x * 512) o[i] = DUMP_F32 == 2 ? ((const float*)src)[(i >> 6) * 384 + DUMP_STRIDE * 64 + (i & 63)] : DUMP_F32 ? ((const float*)src)[i * DUMP_STRIDE] : bf2f(src[i * DUMP_STRIDE]);
        return; }
#endif
#if (PHMASK >> 7) & 1
    { PP P = fresh_params(); char* ws = P->ws; const int tid = threadIdx.x, lane = tid & 63, wid = __builtin_amdgcn_readfirstlane(tid >> 6); Sched S; (void)lane; (void)wid; (void)S; (void)ws;
    { S.init(MTOK, 8192, 2048, ws + HN, ws + WT_UP); S.set_tail(4); S.part = (float*)(ws + R12);
      float* rsb = (float*)(ws + RSB) + (size_t)blockIdx.x * 2048;
      { const float* ssq = (const float*)(ws + SSQ1); Unit u;
        for (int i = 0; i < 8 && S.next(i, u); ++i) if (tid < 256) { const int r = u.pm * BM + tid; const f32x4* sp = (const f32x4*)ssq + r; f32x4 t = sp[0];
#pragma unroll
            for (int k = 1; k < 8; ++k) t += sp[(size_t)k * MTOK];
            rsb[i * 256 + tid] = rsqrtf((t[0] + t[1] + t[2] + t[3]) * (1.0f / 2048.0f) + 1e-6f); }
        asm volatile("s_waitcnt vmcnt(0)" ::: "memory"); __syncthreads(); }
      EpiUp E{rsb, (bf16_t*)P->out, (bf16_t*)(ws + ACTB)};
      gemm_phase(lds, opaque(2048), S, E); }
    }
    GRID_SYNC();
    { PP P = fresh_params(); char* ws = P->ws; const int t = threadIdx.x, rl = blockIdx.x;
      if (rl < 256) { const int r = MPR + rl; const float* ssq = (const float*)(ws + SSQ1); const float* part = (const float*)(ws + R12);
        float tq = 0.f;
#pragma unroll
        for (int k = 0; k < 8; ++k) { const f32x4 q = *((const f32x4*)ssq + (size_t)k * MTOK + r); tq += (q[0] + q[1]) + (q[2] + q[3]); }
        const float rs = rsqrtf(tq * (1.0f / 2048.0f) + 1e-6f);
        bf16_t* dst = (bf16_t*)(ws + ACTB) + (size_t)(r - ACT_SPLIT * BM) * 8192;
        for (int c = t * 4; c < 8192; c += 2048) { f32x4 a = *(const f32x4*)(part + (size_t)rl * 8192 + c);
#pragma unroll
            for (int sl = 1; sl < 4; ++sl) a += *(const f32x4*)(part + ((size_t)sl * 256 + rl) * 8192 + c);
#pragma unroll
            for (int j = 0; j < 4; ++j) { const float z = fmaxf(a[j] * rs, 0.f); a[j] = z * z; }
            *(u32x2*)(dst + c) = pack4(a); } }
    }
    GRID_SYNC();
#endif
#if (PHMASK >> 8) & 1
    { PP P = fresh_params(); char* ws = P->ws; const int tid = threadIdx.x, lane = tid & 63, wid = __builtin_amdgcn_readfirstlane(tid >> 6); Sched S; (void)lane; (void)wid; (void)S; (void)ws;
    { S.init(MTOK, 2048, 8192, P->out, ws + WT_DN); S.splitpm = ACT_SPLIT; S.A0b = ws + ACTB;
      EpiDown E{(float*)(ws + X1), (bf16_t*)(ws + X2B)};
      S.set_tail(8); S.part = (float*)(ws + YR);
      gemm_phase(lds, opaque(8192), S, E);
      if (blockIdx.x >= 64) {
          Sched SP; SP.init(MTOK, 2048, 256, ws + PEB, ws + WT_PP); SP.G = gridDim.x - 64; SP.c = blockIdx.x - 64;
          EpiP E0{(bf16_t*)(ws + PBUF)}; gemm_phase(lds, opaque(256), SP, E0); } }
    }
    GRID_SYNC();
    { PP P = fresh_params(); char* ws = P->ws; const int t = threadIdx.x, rl = blockIdx.x;
      if (rl < 256) { const int c = t * 4; const size_t o = (size_t)(MPR + rl) * DM + c;
        const f32x4 x = *(const f32x4*)((const float*)(ws + X1) + o) + part_sum((const float*)(ws + YR), 0, 8, rl, c);
        *(f32x4*)((float*)(ws + X1) + o) = x; *(u32x2*)((bf16_t*)(ws + X2B) + o) = pack4(x); }
    }
    GRID_SYNC();
#endif
#if (PHMASK >> 9) & 1
    { PP P = fresh_params(); char* ws = P->ws; const int tid = threadIdx.x, lane = tid & 63, wid = __builtin_amdgcn_readfirstlane(tid >> 6); Sched S; (void)lane; (void)wid; (void)S; (void)ws;
    {
      S.init(MTOK, 2048, 2048, ws + X2B, ws + WT_PG);
      EpiGate E{(const float*)(ws + X1), (const bf16_t*)(ws + PBUF), P->out, (float*)(ws + SSQ2)};
      S.set_tail(8); S.part = (float*)(ws + YR);
      gemm_phase(lds, opaque(2048), S, E); }
    }
    GRID_SYNC();
    { PP P = fresh_params(); char* ws = P->ws; const int t = threadIdx.x, rl = blockIdx.x;
      if (rl < 256) { const int c = t * 4, r = MPR + rl; const size_t o = (size_t)r * DM + c; LAS float* red = (LAS float*)lds;
        const f32x4 a = part_sum((const float*)(ws + YR), 0, 8, rl, c), p = unpack4(*(const u32x2*)((const bf16_t*)(ws + PBUF) + o)); f32x4 x = *(const f32x4*)((const float*)(ws + X1) + o);
#pragma unroll
        for (int j = 0; j < 4; ++j) x[j] += sigmoidf_(a[j]) * p[j];
        const float ws_ = wave_sum(x[0] * x[0] + x[1] * x[1] + x[2] * x[2] + x[3] * x[3]);
        if ((t & 63) == 0) red[t >> 6] = ws_;
        __syncthreads();
        float tot = 0.f;
#pragma unroll
        for (int k = 0; k < 8; ++k) tot += red[k];
        const float rs = rsqrtf(tot * (1.0f / 2048.0f) + 1e-6f);
        *(f32x4*)(P->out + o) = x * rs * *(const f32x4*)(P->in[30] + c); }
      __syncthreads();
    }
#endif
#if (PHMASK >> 10) & 1
    { PP P = fresh_params(); char* ws = P->ws; const int tid = threadIdx.x, lane = tid & 63, wid = __builtin_amdgcn_readfirstlane(tid >> 6); Sched S; (void)lane; (void)wid; (void)S; (void)ws;
    { const float* gf = P->in[30]; const float* ssq = (const float*)(ws + SSQ2);
      for (int r = blockIdx.x * 8 + wid; r < MPR; r += gridDim.x * 8) {
          float t = lane < 32 ? ssq[((size_t)(lane >> 2) * MTOK + r) * 4 + (lane & 3)] : 0.f; t = wave_sum(t); const float rs = rsqrtf(t * (1.0f / 2048.0f) + 1e-6f);
          float* x = P->out + (size_t)r * DM;
#pragma unroll
          for (int i = 0; i < 8; ++i) { const f32x4 v = *(const f32x4*)(x + i * 256 + lane * 4), g = *(const f32x4*)(gf + i * 256 + lane * 4); *(f32x4*)(x + i * 256 + lane * 4) = v * rs * g; }
      } }
    }
#endif
}

extern "C" void kernel_launch(void* const* d_in, const int* in_sizes, int n_in, void* d_out, int out_size, void* d_ws, size_t ws_size, hipStream_t stream) {
    static int grid_blocks = 0;
    if (!grid_blocks) {
        int dev = 0, cus = 0, per_cu = 0;
        hipGetDevice(&dev);
        hipFuncSetAttribute((const void*)fwd_megakernel, hipFuncAttributeMaxDynamicSharedMemorySize, (int)LDS_BYTES);
        hipDeviceGetAttribute(&cus, hipDeviceAttributeMultiprocessorCount, dev);
        hipOccupancyMaxActiveBlocksPerMultiprocessor(&per_cu, fwd_megakernel, 512, LDS_BYTES);
        grid_blocks = cus * (per_cu > 0 ? 1 : 0);
        if (grid_blocks > 256) grid_blocks = 256;
        if (ws_size < WS_END) fprintf(stderr, "workspace too small: %zu < %zu\n", ws_size, (size_t)WS_END);
    }
    Params p{};
    for (int i = 0; i < 31; ++i) p.in[i] = (const float*)d_in[i];
    p.out = (float*)d_out; p.ws = (char*)d_ws;
    (void)hipMemsetAsync((char*)d_ws + XBAR, 0, XCD_BAR_WORDS * sizeof(unsigned), stream);
    void* args[] = {&p};
    hipError_t e = hipLaunchCooperativeKernel((const void*)fwd_megakernel, dim3(grid_blocks), dim3(512), args, LDS_BYTES, stream);
    if (e != hipSuccess) fprintf(stderr, "cooperative launch failed: %s (grid %d)\n", hipGetErrorString(e), grid_blocks);
}
```

```cpp
#include <hip/hip_runtime.h>
#include <hip/hip_cooperative_groups.h>
#include <cstdio>
namespace cg = cooperative_groups;

#define LAS __attribute__((address_space(3)))
typedef unsigned short bf16_t;
typedef short bf16x8 __attribute__((ext_vector_type(8)));
typedef float f32x4 __attribute__((ext_vector_type(4)));
typedef float f32x2 __attribute__((ext_vector_type(2)));
typedef unsigned u32x4 __attribute__((ext_vector_type(4)));
typedef unsigned u32x2 __attribute__((ext_vector_type(2)));

constexpr int BM = 256, BK = 64, HALF = 128, HTB = HALF * BK * 2, STAGE_BYTES = 8 * HTB, NXCD = 8, WGM = 8;
constexpr int MTOK = 8448, MPR = 8192, DM = 2048, RC = 3360, RCL = 3584;
constexpr size_t LDS_BYTES = 147456;

constexpr size_t WT_BA = 0, WT_BR = 4194304, WT_OUT = 8388608, WT_UP = 16777216, WT_DN = 50331648, WT_PP = 83886080, WT_PG = 84934656, WT_LORA = 93323264;
constexpr size_t R12 = 95682560;
constexpr size_t WT_IN = R12, HBUF = R12 + 37748736;
constexpr size_t LORA_OUT = R12, YA = R12 + 51904512;
constexpr size_t MIXED = R12, HN = R12 + 34603008, X2B = R12;
constexpr size_t R3 = 168034304;
constexpr size_t QB = R3, KP = R3 + 17301504, VP = KP + 4194304, KS = VP + 4194304, VS = KS + 2359296;
constexpr size_t YRAW = R3, SREC = R3 + 8388608, YRAW_S = SREC + 6291456;
constexpr size_t ACTB = R3, PBUF = R12 + 34603008;
constexpr size_t SEG = 198443008, SEG_SZ = 25165824;
constexpr size_t YR = 248774656;
constexpr size_t GA = 266076160, GR = 300679168, X1 = GA;
constexpr size_t SSQ1 = 335282176, SSQ2 = SSQ1 + 1081344, BON = SSQ2 + 1081344, PEB = BON + 1081344;
constexpr size_t XBAR = PEB + 4325376;
constexpr size_t RSB = XBAR + 16384;
constexpr size_t WS_END = RSB + 2097152;
constexpr size_t O_COLS = 0, O_LORA_A = 60555264;
constexpr size_t O_KWP = 17301504, O_VWP = 17367040, O_WKVP = 17432576, O_SHP = 17563648, O_KWS = 17570368, O_VWS = 18618944, O_WKVS = 19667520, O_SHS = 21764672;
constexpr int ACT_SPLIT = 15;

#ifndef PHMASK
#define PHMASK 0x7ff
#endif
struct Params { const float* in[31]; float* out; char* ws; };
typedef const Params __attribute__((address_space(4)))* PP;
__device__ __forceinline__ PP fresh_params() { PP p = (PP)__builtin_amdgcn_kernarg_segment_ptr(); asm volatile("" : "+s"(p)); return p; }
__device__ __forceinline__ int opaque(int k) { asm volatile("" : "+s"(k)); return k; }

typedef __bf16 bf16x2_t __attribute__((ext_vector_type(2)));
__device__ __forceinline__ unsigned cvt_pk_bf16(float lo, float hi) { f32x2 v = {lo, hi}; bf16x2_t b = __builtin_convertvector(v, bf16x2_t); return __builtin_bit_cast(unsigned, b); }
__device__ __forceinline__ float bf2f(unsigned short b) { return __uint_as_float(((unsigned)b) << 16); }
__device__ __forceinline__ float bflo(unsigned w) { return __uint_as_float(w << 16); }
__device__ __forceinline__ float bfhi(unsigned w) { return __uint_as_float(w & 0xffff0000u); }
__device__ __forceinline__ u32x2 pack4(f32x4 v) { u32x2 w; w.x = cvt_pk_bf16(v[0], v[1]); w.y = cvt_pk_bf16(v[2], v[3]); return w; }
__device__ __forceinline__ f32x4 unpack4(u32x2 w) { return (f32x4){bflo(w.x), bfhi(w.x), bflo(w.y), bfhi(w.y)}; }
__device__ __forceinline__ float sigmoidf_(float x) { return __builtin_amdgcn_rcpf(1.0f + __expf(-x)); }
__device__ __forceinline__ float wave_sum(float x) {
#pragma unroll
    for (int o = 1; o < 64; o <<= 1) x += __shfl_xor(x, o);
    return x;
}
__device__ __forceinline__ float dppf(float x, const int ctrl) { return x; }
#define DPP_ADD(x, ctrl) ((x) + __builtin_bit_cast(float, __builtin_amdgcn_update_dpp(0, __builtin_bit_cast(int, (x)), (ctrl), 0xF, 0xF, true)))
__device__ __forceinline__ float row16_sum(float x) {
    x = DPP_ADD(x, 0xB1); x = DPP_ADD(x, 0x4E); x = DPP_ADD(x, 0x141); x = DPP_ADD(x, 0x140); return x;
}

__host__ __device__ __forceinline__ int lds_byte(int r, int c) { const int st = (r >> 4) * 2 + (c >> 5), rr = r & 15, cc = c & 31, ob = rr * 64 + cc * 2; return st * 1024 + (ob ^ (((ob >> 9) & 1) << 5)); }
__host__ __device__ __forceinline__ void stage_rc(int b, int& R, int& C) { const int st = b / 1024, sb = b % 1024, swz = sb ^ (((sb >> 9) & 1) << 5); R = (st >> 1) * 16 + swz / 64; C = (st & 1) * 32 + (swz % 64) / 2; }

struct Unit { int pm, pn, sub, zero, ui, nt, part; const char* A; const char* B; };
struct Sched {
    int nM, nN, nwg, G, c, dual, splitpm, ntfull, tail, sk, ntslice; size_t tstep; float* part; int tail_i, partld, ngem, nosub;
    const char *A0, *A0b, *B0, *A1, *B1;
    __device__ __forceinline__ void init(int M, int N, int K, const void* A, const void* B) { nM = M / BM; nN = N / BM; nwg = nM * nN; G = gridDim.x; c = blockIdx.x; dual = 0; splitpm = 1 << 30; ntfull = K / BK; tail = 0; sk = 1; ntslice = 0; part = nullptr; ngem = 1; nosub = 0; tstep = (size_t)BM * K * 2; A0 = (const char*)A; A0b = A0; B0 = (const char*)B; A1 = A0; B1 = B0; }
    __device__ __forceinline__ void set_tail(int sk_) { tail = 1; sk = sk_; ntslice = ntfull / sk_; nM = 32; nwg = nM * nN; tail_i = (dual ? 2 : 1) * (nwg / G); partld = nN * BM; ngem = dual ? 2 : 1; }
    __device__ __forceinline__ bool next(int i, Unit& u) const {
        if (tail && i >= tail_i) {
            const int j = c, nsl = ngem * sk;
            if (nosub || i != tail_i || j >= nN * nsl) return false;
            const int sl = j / nN; u.pn = j % nN; u.pm = 32; u.sub = sl / sk; u.zero = 1; u.ui = i; u.nt = ntslice; u.part = sl;
            const size_t koff = (size_t)(sl % sk) * ntslice * BK * 2;
            const char* ab = u.sub ? A1 : (u.pm >= splitpm ? A0b - (size_t)splitpm * tstep : A0);
            u.A = ab + (size_t)u.pm * tstep + koff; u.B = (u.sub ? B1 : B0) + (size_t)u.pn * tstep + koff;
            return true;
        }
        const int ti = dual ? (i >> 1) : i;
        const long L = (long)ti * G + c; if (L >= nwg) return false;
        int wgid = (int)L; { const int q = nwg / NXCD, r = nwg % NXCD, xcd = wgid % NXCD, off = wgid / NXCD; wgid = (xcd < r ? xcd * (q + 1) : r * (q + 1) + (xcd - r) * q) + off; }
        const int nig = WGM * nN, gid = wgid / nig, fm = gid * WGM, gsz = (nM - fm) < WGM ? (nM - fm) : WGM;
        u.pm = fm + ((wgid % nig) % gsz); u.pn = (wgid % nig) / gsz;
        u.sub = dual ? (i & 1) : 0; u.zero = (u.sub == 0); u.ui = i; u.nt = ntfull; u.part = -1;
        const char* ab = u.sub ? A1 : (u.pm >= splitpm ? A0b - (size_t)splitpm * tstep : A0);
        u.A = ab + (size_t)u.pm * tstep; u.B = (u.sub ? B1 : B0) + (size_t)u.pn * tstep;
        return true;
    }
};

template <class Epi>
__device__ __forceinline__ void gemm_phase(LAS unsigned char* lds, const int K, const Sched& S, const Epi& E) {
    int tid = threadIdx.x; asm volatile("" : "+v"(tid));
    const int wid = __builtin_amdgcn_readfirstlane(tid >> 6), lane = tid & 63, wr = wid >> 2, wc = wid & 3, fr = lane & 15, fq = lane >> 4;
    unsigned voffA[2], voffB[2];
#pragma unroll
    for (int i = 0; i < 2; ++i) { int R, C; stage_rc(tid * 16 + i * 8192, R, C); voffA[i] = (unsigned)(R * K + C) * 2u;
        const int rho = R & 31, Rb = (R & ~31) + 8 * ((rho & 15) >> 2) + 4 * (rho >> 4) + (rho & 3); voffB[i] = (unsigned)(Rb * K + C) * 2u; }
    const size_t kstep = (size_t)(BK * 2);
    const size_t hstep = (size_t)HALF * K * 2;
    const unsigned ldsw = (unsigned)wid * 1024u;
    const int aoff = lds_byte(wr * 64 + fr, fq * 8), boff = lds_byte(wc * 32 + fr, fq * 8);
#define PG8_SA(b, h) (((b) * 2 + (h)) * HTB)
#define PG8_SB(b, h) ((4 + (b) * 2 + (h)) * HTB)
#define PG8_STAGE(bufoff, gbase, voff) do { _Pragma("unroll") for (int _i = 0; _i < 2; ++_i) \
        __builtin_amdgcn_global_load_lds((const unsigned*)((const char*)(gbase) + (voff)[_i]), (LAS unsigned*)(lds + (bufoff) + ldsw + _i * 8192), 16, 0, 0); } while (0)
#define PG8_LDA(dst, b, h) do { _Pragma("unroll") for (int m = 0; m < 4; ++m) _Pragma("unroll") for (int k = 0; k < 2; ++k) dst[m][k] = *(const LAS bf16x8*)(lds + PG8_SA(b, h) + aoff + m * 2048 + k * 1024); } while (0)
#define PG8_LDB(dst, b, h) do { _Pragma("unroll") for (int n = 0; n < 2; ++n) _Pragma("unroll") for (int k = 0; k < 2; ++k) dst[n][k] = *(const LAS bf16x8*)(lds + PG8_SB(b, h) + boff + n * 2048 + k * 1024); } while (0)
#define PG8_MMA(ai, bj, At, Bt) do { __builtin_amdgcn_s_setprio(1); _Pragma("unroll") for (int m = 0; m < 4; ++m) _Pragma("unroll") for (int n = 0; n < 2; ++n) _Pragma("unroll") for (int k = 0; k < 2; ++k) \
        acc[ai][bj][m][n] = __builtin_amdgcn_mfma_f32_16x16x32_bf16(Bt[n][k], At[m][k], acc[ai][bj][m][n], 0, 0, 0); __builtin_amdgcn_s_setprio(0); } while (0)
#define PG8_WAIT_V(n) asm volatile("s_waitcnt vmcnt(" #n ")" ::: "memory")
#define PG8_WAIT_L(n) asm volatile("s_waitcnt lgkmcnt(" #n ")" ::: "memory")
#define PG8_BAR __builtin_amdgcn_s_barrier()
#define PG8_SCHED __builtin_amdgcn_sched_barrier(0)
    Unit cur, nxt; int ui = 0;
    if (!S.next(0, cur)) return;
    f32x4 acc[2][2][4][2];
#pragma unroll
    for (int a = 0; a < 2; ++a)
#pragma unroll
        for (int b = 0; b < 2; ++b)
#pragma unroll
            for (int m = 0; m < 4; ++m)
#pragma unroll
                for (int n = 0; n < 2; ++n) acc[a][b][m][n] = (f32x4){0.f, 0.f, 0.f, 0.f};
    bf16x8 At[4][2], B0[2][2], B1[2][2];
    const char* cA = cur.A; const char* cB = cur.B;
    PG8_STAGE(PG8_SB(0, 0), cB, voffB); PG8_STAGE(PG8_SA(0, 0), cA, voffA); PG8_STAGE(PG8_SB(0, 1), cB + hstep, voffB); PG8_STAGE(PG8_SA(0, 1), cA + hstep, voffA);
    if (wr == 1) PG8_BAR;
    PG8_WAIT_V(4); PG8_BAR;
    PG8_STAGE(PG8_SB(1, 0), cB + kstep, voffB); PG8_STAGE(PG8_SA(1, 0), cA + kstep, voffA); PG8_STAGE(PG8_SB(1, 1), cB + hstep + kstep, voffB);
    PG8_WAIT_V(6); PG8_BAR;
    for (;;) {
        const bool has_next = S.next(ui + 1, nxt);
        const char* nA = has_next ? nxt.A : cA; const char* nB = has_next ? nxt.B : cB;
        const int nt = cur.nt;
        for (int t = 0; t < nt; t += 2) {
            const bool last = (t == nt - 2);
            const char* a1 = cA + (size_t)(t + 1) * kstep;
            const char* a2 = last ? nA : cA + (size_t)(t + 2) * kstep; const char* b2 = last ? nB : cB + (size_t)(t + 2) * kstep;
            const char* a3 = a2 + kstep; const char* b3 = b2 + kstep;
            PG8_LDB(B0, 0, 0); PG8_SCHED; PG8_LDA(At, 0, 0); PG8_STAGE(PG8_SA(1, 1), a1 + hstep, voffA);
            PG8_WAIT_L(8); PG8_BAR; PG8_WAIT_L(0); PG8_MMA(0, 0, At, B0); PG8_BAR; PG8_SCHED;
            PG8_LDB(B1, 0, 1); PG8_STAGE(PG8_SB(0, 0), b2, voffB);
            PG8_BAR; PG8_WAIT_L(0); PG8_MMA(0, 1, At, B1); PG8_BAR;
            PG8_LDA(At, 0, 1); PG8_STAGE(PG8_SA(0, 0), a2, voffA);
            PG8_BAR; PG8_WAIT_L(0); PG8_MMA(1, 0, At, B0); PG8_BAR; PG8_SCHED;
            PG8_STAGE(PG8_SB(0, 1), b2 + hstep, voffB);
            PG8_WAIT_V(6); PG8_BAR; PG8_MMA(1, 1, At, B1); PG8_BAR;
            PG8_LDB(B0, 1, 0); PG8_SCHED; PG8_LDA(At, 1, 0); PG8_STAGE(PG8_SA(0, 1), a2 + hstep, voffA);
            PG8_WAIT_L(8); PG8_BAR; PG8_WAIT_L(0); PG8_MMA(0, 0, At, B0); PG8_BAR; PG8_SCHED;
            PG8_LDB(B1, 1, 1); PG8_STAGE(PG8_SB(1, 0), b3, voffB);
            PG8_BAR; PG8_WAIT_L(0); PG8_MMA(0, 1, At, B1); PG8_BAR;
            PG8_LDA(At, 1, 1); PG8_STAGE(PG8_SA(1, 0), a3, voffA);
            PG8_BAR; PG8_WAIT_L(0); PG8_MMA(1, 0, At, B0); PG8_BAR; PG8_SCHED;
            PG8_STAGE(PG8_SB(1, 1), b3 + hstep, voffB);
            PG8_WAIT_V(6); PG8_BAR; PG8_MMA(1, 1, At, B1); PG8_BAR;
        }
        if (cur.part >= 0) {
            float* pp = S.part + (size_t)cur.part * 256 * Epi::PARTLD + (size_t)(wr * 64 + fr) * Epi::PARTLD + cur.pn * 256 + wc * 32 + 8 * fq;
#pragma unroll
            for (int ai = 0; ai < 2; ++ai)
#pragma unroll
                for (int m = 0; m < 4; ++m)
#pragma unroll
                    for (int bj = 0; bj < 2; ++bj)
#pragma unroll
                        for (int n = 0; n < 2; ++n)
                            *(f32x4*)(pp + (size_t)(ai * HALF + m * 16) * Epi::PARTLD + bj * HALF + n * 4) = acc[ai][bj][m][n];
        } else E(acc, cur, wr, wc, fr, fq);
        if (!has_next) break;
        if (nxt.zero) {
#pragma unroll
            for (int a = 0; a < 2; ++a)
#pragma unroll
                for (int b = 0; b < 2; ++b)
#pragma unroll
                    for (int m = 0; m < 4; ++m)
#pragma unroll
                        for (int n = 0; n < 2; ++n) acc[a][b][m][n] = (f32x4){0.f, 0.f, 0.f, 0.f};
        }
        cur = nxt; cA = nA; cB = nB; ++ui;
    }
    PG8_WAIT_V(0);
    if (wr == 0) PG8_BAR;
    PG8_BAR;
#undef PG8_SA
#undef PG8_SB
#undef PG8_STAGE
#undef PG8_LDA
#undef PG8_LDB
#undef PG8_MMA
#undef PG8_WAIT_V
#undef PG8_WAIT_L
#undef PG8_BAR
#undef PG8_SCHED
}

#define EPI_LOOP_BEGIN \
    _Pragma("unroll") for (int ai = 0; ai < 2; ++ai) _Pragma("unroll") for (int m = 0; m < 4; ++m) { \
        const int r = u.pm * BM + ai * HALF + wr * 64 + m * 16 + fr; \
        _Pragma("unroll") for (int bj = 0; bj < 2; ++bj) _Pragma("unroll") for (int n = 0; n < 2; ++n) { \
            const int cl = bj * HALF + wc * 32 + 8 * fq + 4 * n; f32x4& v = acc[ai][bj][m][n];
#define EPI_LOOP_END } if (m == 3) asm volatile("" ::: "memory"); }

struct EpiIn {
    static constexpr int PARTLD = 2048;
    bf16_t *qb, *kp, *vp, *ks, *vs, *colsb, *ga, *gr; float* out;
    __device__ __forceinline__ void operator()(f32x4 (&acc)[2][2][4][2], const Unit& u, int wr, int wc, int fr, int fq) const {
        const int pn = u.pn;
        if (pn < 4) {
            EPI_LOOP_BEGIN *(u32x2*)(qb + (size_t)r * 1024 + pn * 256 + cl) = pack4(v); EPI_LOOP_END
        } else if (pn < 6) {
            bf16_t* dp = pn == 4 ? kp : vp; bf16_t* ds = pn == 4 ? ks : vs;
            float* owp = out + (pn == 4 ? O_KWP : O_VWP); float* ows = out + (pn == 4 ? O_KWS : O_VWS);
            EPI_LOOP_BEGIN
                if (r < MPR) { *(u32x2*)(dp + (size_t)r * 256 + cl) = pack4(v); const int b = r >> 12, t = r & 4095; if (t >= 3968) *(f32x4*)(owp + (size_t)(b * 128 + t - 3968) * 256 + cl) = v; }
                else { const int rs = r - MPR, b = rs >> 3, t = rs & 7; *(u32x2*)(ds + (size_t)(b * 144 + 128 + t) * 256 + cl) = pack4(v); *(f32x4*)(ows + (size_t)(b * 128 + 120 + t) * 256 + cl) = v; }
            EPI_LOOP_END
        } else if (pn < 20) {
            EPI_LOOP_BEGIN
                const int c = (pn - 6) * 256 + cl;
                if (c < RC) {
                    *(u32x2*)(colsb + (size_t)r * RCL + c) = pack4(v);
                    if (r < MPR) { if ((r & 4095) == 4095) *(f32x4*)(out + O_SHP + (size_t)(r >> 12) * RC + c) = v; }
                    else { if (((r - MPR) & 7) == 7) *(f32x4*)(out + O_SHS + (size_t)((r - MPR) >> 3) * RC + c) = v; }
                }
            EPI_LOOP_END
        } else {
            bf16_t* g = pn < 28 ? ga : gr; const int pb = pn < 28 ? 20 : 28;
            EPI_LOOP_BEGIN
                f32x4 s; s[0] = sigmoidf_(v[0]); s[1] = sigmoidf_(v[1]); s[2] = sigmoidf_(v[2]); s[3] = sigmoidf_(v[3]);
                *(u32x2*)(g + (size_t)r * DM + (pn - pb) * 256 + cl) = pack4(s);
            EPI_LOOP_END
        }
    }
};
struct EpiLora {
    static constexpr int PARTLD = 2048;
    bf16_t* o; const float *w0, *a0;
    __device__ __forceinline__ void operator()(f32x4 (&acc)[2][2][4][2], const Unit& u, int wr, int wc, int fr, int fq) const {
        const int grp = u.pn >> 2;
        EPI_LOOP_BEGIN
            const int c = u.pn * 256 + cl; f32x4 s = v;
            if (grp == 0) { const f32x4 b = *(const f32x4*)(w0 + c); _Pragma("unroll") for (int j = 0; j < 4; ++j) s[j] = sigmoidf_(v[j] + b[j]) * 0.60653066f; }
            else if (grp == 1) { const f32x4 b = *(const f32x4*)(a0 + c - 1024); _Pragma("unroll") for (int j = 0; j < 4; ++j) s[j] = sigmoidf_(v[j] + b[j]); }
            *(u32x2*)(o + (size_t)r * 3072 + c) = pack4(s);
        EPI_LOOP_END
    }
};
struct EpiMix {
    static constexpr int PARTLD = 2048;
    const bf16_t *ga, *gr; bf16_t* mixed; float* dbg;
    __device__ __forceinline__ void operator()(f32x4 (&acc)[2][2][4][2], const Unit& u, int wr, int wc, int fr, int fq) const {
        if (u.sub == 0) {
            EPI_LOOP_BEGIN
                const size_t o = (size_t)r * DM + u.pn * 256 + cl; const f32x4 a = unpack4(*(const u32x2*)(ga + o)), b = unpack4(*(const u32x2*)(gr + o));
                _Pragma("unroll") for (int j = 0; j < 4; ++j) v[j] *= a[j] * __builtin_amdgcn_rcpf(b[j]);
            EPI_LOOP_END
        } else {
            EPI_LOOP_BEGIN
                const size_t o = (size_t)r * DM + u.pn * 256 + cl; const f32x4 b = unpack4(*(const u32x2*)(gr + o));
                *(u32x2*)(mixed + o) = pack4(v * b);
#ifdef PROD_DUMP
                if ((r & 15) == 0) *(f32x4*)(dbg + 16000000 + (size_t)(r >> 4) * DM + u.pn * 256 + cl) = v * b;
#endif
            EPI_LOOP_END
        }
    }
};
struct EpiOut {
    static constexpr int PARTLD = 2048;
    const float *xp, *xs, *gn; bf16_t* x1; float* ssq; bf16_t* hn;
    __device__ __forceinline__ void operator()(f32x4 (&acc)[2][2][4][2], const Unit& u, int wr, int wc, int fr, int fq) const {
#pragma unroll
        for (int ai = 0; ai < 2; ++ai)
#pragma unroll
            for (int m = 0; m < 4; ++m) {
                const int r = u.pm * BM + ai * HALF + wr * 64 + m * 16 + fr;
                const float* xr = r < MPR ? xp + (size_t)r * DM : xs + (size_t)(r - MPR) * DM; float ss = 0.f;
#pragma unroll
                for (int bj = 0; bj < 2; ++bj)
#pragma unroll
                    for (int n = 0; n < 2; ++n) {
                        const int c = u.pn * 256 + bj * HALF + wc * 32 + 8 * fq + 4 * n;
                        const f32x4 x = *(const f32x4*)(xr + c) + acc[ai][bj][m][n]; const f32x4 g = *(const f32x4*)(gn + c);
                        *(u32x2*)(x1 + (size_t)r * DM + c) = pack4(x); *(u32x2*)(hn + (size_t)r * DM + c) = pack4(x * g);
                        ss += x[0] * x[0] + x[1] * x[1] + x[2] * x[2] + x[3] * x[3];
                    }
                ss += __shfl_xor(ss, 16); ss += __shfl_xor(ss, 32);
                if (fq == 0) ssq[((size_t)u.pn * MTOK + r) * 4 + wc] = ss;
            }
    }
};
struct EpiUp {
    static constexpr int PARTLD = 8192;
    const float* rsb; bf16_t *actA, *actB;
    __device__ __forceinline__ void operator()(f32x4 (&acc)[2][2][4][2], const Unit& u, int wr, int wc, int fr, int fq) const {
        bf16_t* base = u.pm < ACT_SPLIT ? actA : actB - (size_t)ACT_SPLIT * BM * 8192;
        float rsv[2][4];
#pragma unroll
        for (int ai = 0; ai < 2; ++ai)
#pragma unroll
            for (int m = 0; m < 4; ++m) rsv[ai][m] = rsb[u.ui * 256 + ai * HALF + wr * 64 + m * 16 + fr];
#pragma unroll
        for (int ai = 0; ai < 2; ++ai)
#pragma unroll
            for (int m = 0; m < 4; ++m) {
                const int r = u.pm * BM + ai * HALF + wr * 64 + m * 16 + fr; const float rs = rsv[ai][m];
#pragma unroll
                for (int bj = 0; bj < 2; ++bj)
#pragma unroll
                    for (int n = 0; n < 2; ++n) {
                        const int c = u.pn * 256 + bj * HALF + wc * 32 + 8 * fq + 4 * n; f32x4 a = acc[ai][bj][m][n] * rs;
#pragma unroll
                        for (int j = 0; j < 4; ++j) { const float z = fmaxf(a[j], 0.f); a[j] = z * z; }
                        *(u32x2*)(base + (size_t)r * 8192 + c) = pack4(a);
                    }
            }
    }
};
struct EpiNone {
    static constexpr int PARTLD = 2048;
    __device__ __forceinline__ void operator()(f32x4 (&acc)[2][2][4][2], const Unit& u, int wr, int wc, int fr, int fq) const {}
};
struct EpiDown {
    static constexpr int PARTLD = 2048;
    const bf16_t* x1; bf16_t* x2b;
    __device__ __forceinline__ void operator()(f32x4 (&acc)[2][2][4][2], const Unit& u, int wr, int wc, int fr, int fq) const {
        EPI_LOOP_BEGIN
            const size_t o = (size_t)r * DM + u.pn * 256 + cl; const f32x4 x = unpack4(*(const u32x2*)(x1 + o)) + v;
            *(u32x2*)(x2b + o) = pack4(x);
        EPI_LOOP_END
    }
};
struct EpiP {
    static constexpr int PARTLD = 2048;
    bf16_t* pb;
    __device__ __forceinline__ void operator()(f32x4 (&acc)[2][2][4][2], const Unit& u, int wr, int wc, int fr, int fq) const {
        EPI_LOOP_BEGIN *(u32x2*)(pb + (size_t)r * DM + u.pn * 256 + cl) = pack4(v); EPI_LOOP_END
    }
};
struct EpiGate {
    static constexpr int PARTLD = 2048;
    const bf16_t* x2; const bf16_t* pb; float *o, *ssq;
    __device__ __forceinline__ void operator()(f32x4 (&acc)[2][2][4][2], const Unit& u, int wr, int wc, int fr, int fq) const {
#pragma unroll
        for (int ai = 0; ai < 2; ++ai)
#pragma unroll
            for (int m = 0; m < 4; ++m) {
                const int r = u.pm * BM + ai * HALF + wr * 64 + m * 16 + fr; float ss = 0.f;
#pragma unroll
                for (int bj = 0; bj < 2; ++bj)
#pragma unroll
                    for (int n = 0; n < 2; ++n) {
                        const size_t of = (size_t)r * DM + u.pn * 256 + bj * HALF + wc * 32 + 8 * fq + 4 * n;
                        const f32x4 a = acc[ai][bj][m][n], p = unpack4(*(const u32x2*)(pb + of)); f32x4 x = unpack4(*(const u32x2*)(x2 + of));
#pragma unroll
                        for (int j = 0; j < 4; ++j) x[j] += sigmoidf_(a[j]) * p[j];
                        *(f32x4*)(o + of) = x; ss += x[0] * x[0] + x[1] * x[1] + x[2] * x[2] + x[3] * x[3];
                    }
                ss += __shfl_xor(ss, 16); ss += __shfl_xor(ss, 32);
                if (fq == 0) ssq[((size_t)u.pn * MTOK + r) * 4 + wc] = ss;
            }
    }
};

__device__ __forceinline__ void conv_t(LAS float* tile, const float* __restrict__ src, int K, int N, bf16_t* dst, int gap_at, int gap) {
    const int tid = threadIdx.x, nNt = (N + 127) >> 7, ntile = (K >> 6) * nNt;
    for (int t = blockIdx.x; t < ntile; t += gridDim.x) {
        const int k0 = (t / nNt) << 6, n0 = (t % nNt) << 7;
        const int row = tid >> 5, c4 = (tid & 31) << 2, n = n0 + c4;
        f32x4 v[4];
#pragma unroll
        for (int rr = 0; rr < 4; ++rr) { v[rr] = (f32x4){0.f, 0.f, 0.f, 0.f}; if (n < N) v[rr] = *(const f32x4*)(src + (size_t)(k0 + row + rr * 16) * N + n); }
#pragma unroll
        for (int rr = 0; rr < 4; ++rr)
#pragma unroll
            for (int i = 0; i < 4; ++i) tile[(row + rr * 16) * 129 + c4 + i] = v[rr][i];
        __syncthreads();
        const int kk = (tid & 7) << 3;
#pragma unroll
        for (int h = 0; h < 2; ++h) { const int nn = (tid >> 3) + h * 64, nq = n0 + nn;
            if (nq < N) {
                const int np = nq + (nq >= gap_at ? gap : 0); u32x4 w;
                w.x = cvt_pk_bf16(tile[(kk + 0) * 129 + nn], tile[(kk + 1) * 129 + nn]); w.y = cvt_pk_bf16(tile[(kk + 2) * 129 + nn], tile[(kk + 3) * 129 + nn]);
                w.z = cvt_pk_bf16(tile[(kk + 4) * 129 + nn], tile[(kk + 5) * 129 + nn]); w.w = cvt_pk_bf16(tile[(kk + 6) * 129 + nn], tile[(kk + 7) * 129 + nn]);
                *(u32x4*)(dst + (size_t)np * K + k0 + kk) = w;
            } }
        __syncthreads();
    }
}

struct ConvJob { const float* src; bf16_t* dst; int K, N, nNt, ntile; };
__device__ __forceinline__ void conv_wave_load(const ConvJob& J, int t, int lane, f32x4 (&v)[8]) {
    const int k0 = (t / J.nNt) << 6, n0 = (t % J.nNt) << 5;
    const float* p = J.src + (size_t)(k0 + (lane >> 3)) * J.N + n0 + ((lane & 7) << 2);
#pragma unroll
    for (int i = 0; i < 8; ++i) v[i] = *(const f32x4*)(p + (size_t)(i * 8) * J.N);
}
__device__ __forceinline__ void conv_wave_store(const ConvJob& J, int t, int lane, const f32x4 (&v)[8], LAS float* tile) {
    const int k0 = (t / J.nNt) << 6, n0 = (t % J.nNt) << 5;
#pragma unroll
    for (int i = 0; i < 8; ++i) *(LAS f32x4*)(tile + ((lane >> 3) + i * 8) * 36 + ((lane & 7) << 2)) = v[i];
    const int nn = lane >> 1, kh = (lane & 1) << 5;
    u32x4 w[4];
#pragma unroll
    for (int j = 0; j < 4; ++j) { const LAS float* tp = tile + (kh + j * 8) * 36 + nn;
        w[j].x = cvt_pk_bf16(tp[0], tp[36]); w[j].y = cvt_pk_bf16(tp[72], tp[108]); w[j].z = cvt_pk_bf16(tp[144], tp[180]); w[j].w = cvt_pk_bf16(tp[216], tp[252]); }
    bf16_t* d = J.dst + (size_t)(n0 + nn) * J.K + k0 + kh;
#pragma unroll
    for (int j = 0; j < 4; ++j) *(u32x4*)(d + j * 8) = w[j];
}
__device__ __forceinline__ void conv_wave_run(const ConvJob& J, int slot, int nslots, int lane, LAS float* tile) {
    f32x4 v[8];
    for (int t = slot; t < J.ntile; t += nslots) { conv_wave_load(J, t, lane, v); conv_wave_store(J, t, lane, v, tile); }
}
__device__ __forceinline__ void phase0(PP P, LAS unsigned char* lds) {
    char* ws = P->ws; const int tid = threadIdx.x, lane = tid & 63, wid = tid >> 6;
    const size_t gtid = (size_t)blockIdx.x * 512 + tid, gsz = (size_t)gridDim.x * 512;
    LAS float* tile = (LAS float*)lds;
    conv_t(tile, P->in[9], 2048, 8992, (bf16_t*)(ws + WT_IN), 4896, 224);
    { u32x4* z = (u32x4*)(ws + WT_IN + (size_t)4896 * 2048 * 2); for (size_t i = gtid; i < (size_t)224 * 2048 * 2 / 16; i += gsz) z[i] = (u32x4){0u, 0u, 0u, 0u}; }
    { const float* gm = P->in[8]; bf16_t* h = (bf16_t*)(ws + HBUF);
      for (int r = blockIdx.x * 8 + wid; r < MTOK; r += gridDim.x * 8) {
          const float* x = r < MPR ? P->in[0] + (size_t)r * DM : P->in[1] + (size_t)(r - MPR) * DM; f32x4 v[8]; float ss = 0.f;
#pragma unroll
          for (int i = 0; i < 8; ++i) { v[i] = *(const f32x4*)(x + i * 256 + lane * 4); ss += v[i][0] * v[i][0] + v[i][1] * v[i][1] + v[i][2] * v[i][2] + v[i][3] * v[i][3]; }
          ss = wave_sum(ss); const float rs = rsqrtf(ss * (1.0f / 2048.0f) + 1e-6f);
#pragma unroll
          for (int i = 0; i < 8; ++i) { const f32x4 g = *(const f32x4*)(gm + i * 256 + lane * 4); *(u32x2*)(h + (size_t)r * DM + i * 256 + lane * 4) = pack4(v[i] * rs * g); }
      } }
}

__device__ __forceinline__ void phase0_late(PP P, int bidx, int nblk) {
    char* ws = P->ws; const int tid = threadIdx.x;
    const size_t gtid = (size_t)bidx * 512 + tid, gsz = (size_t)nblk * 512;
    { bf16_t* L = (bf16_t*)(ws + WT_LORA); const float *w2 = P->in[13], *a2 = P->in[15], *g2 = P->in[16];
      for (size_t i = gtid; i < (size_t)3072 * 384; i += gsz) { const int n = (int)(i / 384), k = (int)(i % 384); float v = 0.f;
          if (n < 1024) { if (k < 64) v = w2[k * 1024 + n]; } else if (n < 2048) { if (k >= 64 && k < 128) v = a2[(k - 64) * 1024 + n - 1024]; } else { if (k >= 128 && k < 288) v = g2[(k - 128) * 1024 + n - 2048]; }
          L[i] = (bf16_t)(cvt_pk_bf16(v, 0.f) & 0xffffu); } }
    { bf16_t* pb = (bf16_t*)(ws + PEB);
      for (size_t i = gtid; i < (size_t)MTOK * 64; i += gsz) { const size_t e = i * 4; const float* s = e < (size_t)MPR * 256 ? P->in[6] + e : P->in[7] + (e - (size_t)MPR * 256); *(u32x2*)(pb + e) = pack4(*(const f32x4*)s); } }
    { bf16_t *ks = (bf16_t*)(ws + KS), *vs = (bf16_t*)(ws + VS);
      for (size_t i = gtid; i < (size_t)32 * 144 * 64; i += gsz) { const int b = (int)(i / (144 * 64)), rem = (int)(i % (144 * 64)), key = rem >> 6, c = (rem & 63) << 2;
          if (key >= 128 && key < 136) continue;
          f32x4 kv = (f32x4){0.f, 0.f, 0.f, 0.f}, vv = kv;
          if (key < 128) { kv = *(const f32x4*)(P->in[2] + ((size_t)b * 128 + key) * 256 + c); vv = *(const f32x4*)(P->in[3] + ((size_t)b * 128 + key) * 256 + c);
              if (key >= 8) { *(f32x4*)(P->out + O_KWS + ((size_t)b * 128 + key - 8) * 256 + c) = kv; *(f32x4*)(P->out + O_VWS + ((size_t)b * 128 + key - 8) * 256 + c) = vv; } }
          *(u32x2*)(ks + ((size_t)b * 144 + key) * 256 + c) = pack4(kv); *(u32x2*)(vs + ((size_t)b * 144 + key) * 256 + c) = pack4(vv); } }
}

constexpr int VT_STRIDE = 168, VT_BYTES = 64 * VT_STRIDE * 2;
__device__ __forceinline__ void attn_job(PP P, LAS bf16_t* vt, int job, int lane) {
    char* ws = P->ws; const int fr = lane & 15, fq = lane >> 4;
    const bool smp = job >= 2048; int b, kvh, q0;
    if (!smp) { const int qt = job >> 2; kvh = job & 3; b = qt >> 8; q0 = (qt & 255) << 4; } else { const int js = job - 2048; b = js >> 2; kvh = js & 3; q0 = 128; }
    const bf16_t* kbase = smp ? (const bf16_t*)(ws + KS) + (size_t)b * 144 * 256 : (const bf16_t*)(ws + KP) + ((size_t)b * 4096 + q0 - 128) * 256;
    const bf16_t* vbase = smp ? (const bf16_t*)(ws + VS) + (size_t)b * 144 * 256 : (const bf16_t*)(ws + VP) + ((size_t)b * 4096 + q0 - 128) * 256;
    const int jmin = smp ? 0 : (128 - q0 > 0 ? 128 - q0 : 0);
    for (int i = lane; i < 160 * 8; i += 64) { const int j = i >> 3, c8 = i & 7; u32x4 w = (u32x4){0u, 0u, 0u, 0u};
        if (j >= jmin && j < 144) w = *(const u32x4*)(vbase + (size_t)j * 256 + kvh * 64 + c8 * 8);
        LAS bf16_t* d = vt + (c8 * 8) * VT_STRIDE + j;
        d[0] = (bf16_t)(w.x & 0xffff); d[VT_STRIDE] = (bf16_t)(w.x >> 16); d[2 * VT_STRIDE] = (bf16_t)(w.y & 0xffff); d[3 * VT_STRIDE] = (bf16_t)(w.y >> 16);
        d[4 * VT_STRIDE] = (bf16_t)(w.z & 0xffff); d[5 * VT_STRIDE] = (bf16_t)(w.z >> 16); d[6 * VT_STRIDE] = (bf16_t)(w.w & 0xffff); d[7 * VT_STRIDE] = (bf16_t)(w.w >> 16); }
    const bf16_t* qrow = (const bf16_t*)(ws + QB) + (smp ? (size_t)(MPR + b * 8 + (fr & 7)) : (size_t)(b * 4096 + q0 + fr)) * 1024;
    bf16_t* orow = (bf16_t*)(ws + YA) + (smp ? (size_t)(MPR + b * 8 + (fr & 7)) : (size_t)(b * 4096 + q0 + fr)) * 1024;
    for (int g = 0; g < 4; ++g) {
        const int hd = kvh * 4 + g; const float slope = exp2f(-0.5f * (float)(hd + 1)), sink = P->in[10][hd];
        const bf16x8 q0f = *(const bf16x8*)(qrow + hd * 64 + fq * 8), q1f = *(const bf16x8*)(qrow + hd * 64 + 32 + fq * 8);
        f32x4 s[9]; float mx = -1e30f;
#pragma unroll
        for (int kt = 0; kt < 9; ++kt) {
            if (kt % 3 == 0) asm volatile("" ::: "memory");
            bf16x8 k0f = (bf16x8){0, 0, 0, 0, 0, 0, 0, 0}, k1f = k0f;
            { const int jk = kt * 16 + fr; if (jk >= jmin) { const bf16_t* kp_ = kbase + (size_t)jk * 256 + kvh * 64 + fq * 8; k0f = *(const bf16x8*)kp_; k1f = *(const bf16x8*)(kp_ + 32); } }
            f32x4 a = __builtin_amdgcn_mfma_f32_16x16x32_bf16(k0f, q0f, (f32x4){0.f, 0.f, 0.f, 0.f}, 0, 0, 0);
            a = __builtin_amdgcn_mfma_f32_16x16x32_bf16(k1f, q1f, a, 0, 0, 0);
#pragma unroll
            for (int j = 0; j < 4; ++j) { const int jp = kt * 16 + fq * 4 + j, dist = 128 + fr - jp; const bool ok = dist >= 0 && dist <= 128 && jp >= jmin;
                a[j] = ok ? a[j] * 0.125f - slope * (float)dist : -1e30f; mx = fmaxf(mx, a[j]); }
            s[kt] = a;
        }
        mx = fmaxf(mx, __shfl_xor(mx, 16)); mx = fmaxf(mx, __shfl_xor(mx, 32));
        const float mm = fmaxf(mx, sink); float sum = 0.f;
#pragma unroll
        for (int kt = 0; kt < 9; ++kt)
#pragma unroll
            for (int j = 0; j < 4; ++j) { const float p = s[kt][j] > -1e29f ? __expf(s[kt][j] - mm) : 0.f; s[kt][j] = p; sum += p; }
        sum += __shfl_xor(sum, 16); sum += __shfl_xor(sum, 32);
        const float inv = 1.0f / (sum + __expf(sink - mm));
        f32x4 o[4];
#pragma unroll
        for (int dt = 0; dt < 4; ++dt) o[dt] = (f32x4){0.f, 0.f, 0.f, 0.f};
#pragma unroll
        for (int pp = 0; pp < 5; ++pp) {
            const f32x4 p0 = s[2 * pp] * inv; f32x4 p1 = (f32x4){0.f, 0.f, 0.f, 0.f}; if (pp < 4) p1 = s[2 * pp + 1] * inv;
            u32x4 pw; pw.x = cvt_pk_bf16(p0[0], p0[1]); pw.y = cvt_pk_bf16(p0[2], p0[3]); pw.z = cvt_pk_bf16(p1[0], p1[1]); pw.w = cvt_pk_bf16(p1[2], p1[3]);
            const bf16x8 pb = __builtin_bit_cast(bf16x8, pw);
#pragma unroll
            for (int dt = 0; dt < 4; ++dt) {
                const LAS bf16_t* vp = vt + (dt * 16 + fr) * VT_STRIDE + pp * 32 + fq * 4;
                u32x4 vw; const u32x2 lo = *(const LAS u32x2*)vp, hi = *(const LAS u32x2*)(vp + 16); vw.x = lo.x; vw.y = lo.y; vw.z = hi.x; vw.w = hi.y;
                o[dt] = __builtin_amdgcn_mfma_f32_16x16x32_bf16(__builtin_bit_cast(bf16x8, vw), pb, o[dt], 0, 0, 0);
            }
        }
        if (!smp || fr < 8) {
#pragma unroll
            for (int dt = 0; dt < 4; ++dt) *(u32x2*)(orow + hd * 64 + dt * 16 + fq * 4) = pack4(o[dt]);
        }
    }
}

__device__ __forceinline__ float xx_col(PP P, const bf16_t* cols, int r, int col) {
    const float c = bf2f(cols[(size_t)r * RCL + col]); float p;
    if (r < MPR) p = (r & 4095) == 0 ? 0.f : bf2f(cols[(size_t)(r - 1) * RCL + col]);
    else { const int rs = r - MPR; p = (rs & 7) == 0 ? P->in[5][(size_t)(rs >> 3) * RC + col] : bf2f(cols[(size_t)(r - 1) * RCL + col]); }
    return c + (p - c) * P->in[11][col];
}
__device__ __forceinline__ void lora_a_phase(PP P) {
    const bf16_t* cols = (const bf16_t*)((const char*)P->out + O_COLS); bf16_t* A = (bf16_t*)((char*)P->out + O_LORA_A);
    const size_t gtid = (size_t)blockIdx.x * 512 + threadIdx.x, gsz = (size_t)gridDim.x * 512;
    for (size_t i = gtid; i < (size_t)MTOK * 96; i += gsz) { const int r = (int)(i / 96), j4 = (int)(i % 96) * 4; f32x4 v = (f32x4){0.f, 0.f, 0.f, 0.f};
        if (j4 < 288) {
#pragma unroll
            for (int j = 0; j < 4; ++j) { const float x = xx_col(P, cols, r, 3072 + j4 + j); v[j] = j4 < 64 ? tanhf(x) : (j4 < 128 ? x : sigmoidf_(x)); } }
        *(u32x2*)(A + (size_t)r * 384 + j4) = pack4(v); }
}
__device__ __forceinline__ f32x4 ld4bf(const bf16_t* p) { return unpack4(*(const u32x2*)p); }
__device__ __forceinline__ f32x4 xx4(PP P, const bf16_t* cols, int r, int col) {
    const f32x4 c = ld4bf(cols + (size_t)r * RCL + col); f32x4 p = (f32x4){0.f, 0.f, 0.f, 0.f};
    if (r < MPR) { if ((r & 4095) != 0) p = ld4bf(cols + (size_t)(r - 1) * RCL + col); }
    else { const int rs = r - MPR; if ((rs & 7) == 0) p = *(const f32x4*)(P->in[5] + (size_t)(rs >> 3) * RC + col); else p = ld4bf(cols + (size_t)(r - 1) * RCL + col); }
    return c + (p - c) * *(const f32x4*)(P->in[11] + col);
}
__device__ __forceinline__ float quad_sum(float x) { x = DPP_ADD(x, 0xB1); x = DPP_ADD(x, 0x4E); return x; }
__device__ __forceinline__ float hsum4(f32x4 v) { return (v[0] + v[1]) + (v[2] + v[3]); }
__device__ __forceinline__ void prep_token(PP P, int r, int lane, float* rec0, size_t hstride) {
    const bf16_t* cols = (const bf16_t*)((const char*)P->out + O_COLS); const bf16_t* lo = (const bf16_t*)(P->ws + LORA_OUT) + (size_t)r * 3072;
    const int hd = lane >> 2, sub = lane & 3, ch0 = lane * 16;
    float ss = 0.f, bon = 0.f;
#pragma unroll 1
    for (int q = 0; q < 4; ++q) { const int c = ch0 + q * 4;
        const f32x4 xr = xx4(P, cols, r, c), xk = xx4(P, cols, r, 1024 + c), a = ld4bf(lo + 1024 + c);
        const f32x4 kk = xk * *(const f32x4*)(P->in[17] + c); ss += hsum4(kk * kk);
        const f32x4 k32 = xk * (1.0f + (a - 1.0f) * *(const f32x4*)(P->in[18] + c));
        bon += hsum4(xr * k32 * *(const f32x4*)(P->in[19] + c)); }
    ss = quad_sum(ss); bon = quad_sum(bon);
    const float inv = rsqrtf(fmaxf(ss, 1e-24f));
    if (sub == 0) ((float*)(P->ws + BON))[(size_t)r * 32 + hd] = bon;
    float* rec = rec0 + (size_t)hd * hstride + sub * 16;
#pragma unroll 1
    for (int q = 0; q < 4; ++q) { const int c = ch0 + q * 4;
        const f32x4 xr = xx4(P, cols, r, c), xk = xx4(P, cols, r, 1024 + c), xv = xx4(P, cols, r, 2048 + c), e = ld4bf(lo + c), a = ld4bf(lo + 1024 + c);
        const f32x4 kn = xk * *(const f32x4*)(P->in[17] + c) * inv;
        const f32x4 k32 = xk * (1.0f + (a - 1.0f) * *(const f32x4*)(P->in[18] + c));
        f32x4 w;
#pragma unroll
        for (int j = 0; j < 4; ++j) w[j] = __expf(-e[j]);
        *(f32x4*)(rec + q * 4) = -kn; *(f32x4*)(rec + 64 + q * 4) = w; *(f32x4*)(rec + 128 + q * 4) = kn * a;
        *(f32x4*)(rec + 192 + q * 4) = k32; *(f32x4*)(rec + 256 + q * 4) = xr; *(f32x4*)(rec + 320 + q * 4) = xv; }
}
__device__ __forceinline__ void post_token(PP P, int r, int lane, const f32x4 (&y)[4]) {
    const bf16_t* cols = (const bf16_t*)((const char*)P->out + O_COLS); const bf16_t* lo = (const bf16_t*)(P->ws + LORA_OUT) + (size_t)r * 3072;
    const int hd = lane >> 2, ch0 = lane * 16;
    const float mean = quad_sum(hsum4(y[0]) + hsum4(y[1]) + hsum4(y[2]) + hsum4(y[3])) * (1.0f / 64.0f);
    float vs = 0.f;
#pragma unroll
    for (int q = 0; q < 4; ++q) { const f32x4 d = y[q] - mean; vs += hsum4(d * d); }
    const float rstd = rsqrtf(quad_sum(vs) * (1.0f / 64.0f) + 64e-5f), bon = ((const float*)(P->ws + BON))[(size_t)r * 32 + hd];
#pragma unroll
    for (int q = 0; q < 4; ++q) { const int c = ch0 + q * 4;
        f32x4 yn = (y[q] - mean) * rstd * *(const f32x4*)(P->in[20] + c) + *(const f32x4*)(P->in[21] + c);
        yn += bon * xx4(P, cols, r, 2048 + c);
        *(u32x2*)((bf16_t*)(P->ws + YR) + (size_t)r * 1024 + c) = pack4(yn * ld4bf(lo + 2048 + c)); }
}
struct StepOps { f32x4 nk, w, ka, k, r; float vv; };
__device__ __forceinline__ float wkv_step(f32x4& S, const StepOps& o) {
    f32x2 s01 = {S[0], S[1]}, s23 = {S[2], S[3]};
    f32x2 t = s01 * (f32x2){o.nk[0], o.nk[1]}; t = __builtin_elementwise_fma(s23, (f32x2){o.nk[2], o.nk[3]}, t);
    const float sa = row16_sum(t[0] + t[1]);
    const f32x2 sa2 = {sa, sa}, vv2 = {o.vv, o.vv};
    f32x2 u01 = (f32x2){o.k[0], o.k[1]} * vv2, u23 = (f32x2){o.k[2], o.k[3]} * vv2;
    u01 = __builtin_elementwise_fma((f32x2){o.ka[0], o.ka[1]}, sa2, u01); u23 = __builtin_elementwise_fma((f32x2){o.ka[2], o.ka[3]}, sa2, u23);
    s01 = __builtin_elementwise_fma(s01, (f32x2){o.w[0], o.w[1]}, u01); s23 = __builtin_elementwise_fma(s23, (f32x2){o.w[2], o.w[3]}, u23);
    S = (f32x4){s01[0], s01[1], s23[0], s23[1]};
    f32x2 y = s01 * (f32x2){o.r[0], o.r[1]}; y = __builtin_elementwise_fma(s23, (f32x2){o.r[2], o.r[3]}, y);
    return y[0] + y[1];
}
__device__ __forceinline__ void lds_step(StepOps& o, const LAS float* rp, int li, int row) {
    o.nk = *(const LAS f32x4*)(rp + li * 4); o.w = *(const LAS f32x4*)(rp + 64 + li * 4); o.ka = *(const LAS f32x4*)(rp + 128 + li * 4);
    o.k = *(const LAS f32x4*)(rp + 192 + li * 4); o.r = *(const LAS f32x4*)(rp + 256 + li * 4); o.vv = rp[320 + row];
}
__device__ __forceinline__ void scan_issue(const float* recs, LAS unsigned char* lb, int c, int lane) {
    const char* gp = (const char*)recs + (size_t)c * 12288 + lane * 16; LAS unsigned char* lp = lb + (c & 3) * 12288;
#pragma unroll
    for (int g = 0; g < 3; ++g) {
        __builtin_amdgcn_global_load_lds((const unsigned*)(gp + g * 4096), (LAS unsigned*)(lp + g * 4096), 16, 0, 0);
        __builtin_amdgcn_global_load_lds((const unsigned*)(gp + g * 4096), (LAS unsigned*)(lp + g * 4096), 16, 1024, 0);
        __builtin_amdgcn_global_load_lds((const unsigned*)(gp + g * 4096), (LAS unsigned*)(lp + g * 4096), 16, 2048, 0);
        __builtin_amdgcn_global_load_lds((const unsigned*)(gp + g * 4096), (LAS unsigned*)(lp + g * 4096), 16, 3072, 0);
    }
}
__device__ __forceinline__ void scan_seg(const float* recs, LAS float* lbf, f32x4& S, float* yout, int row, int ycol, int lane) {
    const int li = lane & 15; LAS unsigned char* lb = (LAS unsigned char*)lbf;
    scan_issue(recs, lb, 0, lane); scan_issue(recs, lb, 1, lane); scan_issue(recs, lb, 2, lane);
    asm volatile("s_waitcnt vmcnt(24)" ::: "memory");
    StepOps cur, n1, n2; lds_step(cur, lbf, li, row); lds_step(n1, lbf + 384, li, row);
#pragma unroll 12
    for (int c = 0; c < 64; ++c) {
        const LAS float* bcur = lbf + (c & 3) * 3072; const LAS float* bnxt = lbf + ((c + 1) & 3) * 3072;
        float yp[8];
#pragma unroll
        for (int tt = 0; tt < 8; ++tt) {
            if (tt == 1 && c + 3 < 64) scan_issue(recs, lb, c + 3, lane);
            if (tt == 5) { if (c < 61) asm volatile("s_waitcnt vmcnt(24)" ::: "memory"); else if (c == 61) asm volatile("s_waitcnt vmcnt(12)" ::: "memory"); else asm volatile("s_waitcnt vmcnt(0)" ::: "memory"); }
            if (tt < 6) lds_step(n2, bcur + (tt + 2) * 384, li, row);
            else if (c < 63) lds_step(n2, bnxt + (tt - 6) * 384, li, row);
            yp[tt] = wkv_step(S, cur);
            cur = n1; n1 = n2;
        }
        float ysel = 0.f;
#pragma unroll
        for (int tt = 0; tt < 8; ++tt) { const float y = row16_sum(yp[tt]); ysel = (li == tt) ? y : ysel; }
        if (li < 8) yout[(size_t)(c * 8 + li) * 8 + ycol] = ysel;
    }
}
__device__ __forceinline__ void scan_sample_job(PP P, int q, int lane) {
    const int bh = q >> 4, row = (q & 15) * 4 + (lane >> 4), li = lane & 15;
    f32x4 S = *(const f32x4*)(P->in[4] + ((size_t)bh * 64 + row) * 64 + li * 4);
    const float* rec = (const float*)(P->ws + SREC) + (size_t)bh * 8 * 384; float* yo = (float*)(P->ws + YRAW_S);
    float ysel = 0.f;
#pragma unroll
    for (int hb = 0; hb < 2; ++hb) {
        StepOps o[4];
#pragma unroll
        for (int t = 0; t < 4; ++t) { const float* rp = rec + (hb * 4 + t) * 384;
            o[t].nk = *(const f32x4*)(rp + li * 4); o[t].w = *(const f32x4*)(rp + 64 + li * 4); o[t].ka = *(const f32x4*)(rp + 128 + li * 4);
            o[t].k = *(const f32x4*)(rp + 192 + li * 4); o[t].r = *(const f32x4*)(rp + 256 + li * 4); o[t].vv = rp[320 + row]; }
#pragma unroll
        for (int t = 0; t < 4; ++t) { const float y = row16_sum(wkv_step(S, o[t])); ysel = (li == hb * 4 + t) ? y : ysel; }
    }
    if (li < 8) yo[((size_t)q * 8 + li) * 4 + (lane >> 4)] = ysel;
    *(f32x4*)(P->out + O_WKVS + ((size_t)bh * 64 + row) * 64 + li * 4) = S;
}

#define XB_TMO      128
#define XB_XCNT(j)  (256  + 64 * (j))
#define XB_XSUB(j)  (1280 + 64 * (j))
#define XB_XGEN(j)  (2304 + 64 * (j))
#define XB_TOP      3328
#define XB_TOPGEN   3392
#define XCD_BAR_WORDS 3456
#define XB_SPIN_CAP (1u << 18)
__device__ __forceinline__ unsigned xb_ld(unsigned* p)              { return __hip_atomic_load(p, __ATOMIC_RELAXED, __HIP_MEMORY_SCOPE_AGENT); }
__device__ __forceinline__ unsigned xb_add(unsigned* p, unsigned v) { return __hip_atomic_fetch_add(p, v, __ATOMIC_RELAXED, __HIP_MEMORY_SCOPE_AGENT); }
__device__ __forceinline__ unsigned xb_xcc_id() { return (unsigned)__builtin_amdgcn_s_getreg((3 << 11) | 20) & 0xFu; }
#define XB_SPIN(cond, bar) do { unsigned _sp = 0; while (cond) { __builtin_amdgcn_s_sleep(1); \
    if ((++_sp & 255u) == 0u) { if (xb_ld(&(bar)[XB_TMO])) break; if (_sp > XB_SPIN_CAP) { atomicAdd(&(bar)[XB_TMO], 1u); break; } } } } while (0)
struct XcdBarrier { unsigned* bar; unsigned x; volatile LAS unsigned* st; };
__device__ __forceinline__ XcdBarrier xcd_barrier_post(unsigned* bar, volatile LAS unsigned* st) {
    XcdBarrier b; b.bar = bar; b.x = xb_xcc_id(); b.st = st;
    if (threadIdx.x == 0) (void)xb_add(&bar[XB_XCNT(b.x)], 1u);
    return b;
}
__device__ __forceinline__ void xcd_barrier_complete(unsigned* bar, unsigned x, unsigned& nloc, unsigned& nx) {
    const unsigned G = gridDim.x * gridDim.y * gridDim.z;
    unsigned sum, cnt, mine, sp = 0u;
    for (;;) {
        sum = 0u; cnt = 0u; mine = 0u;
#pragma unroll
        for (unsigned j = 0; j < 16; ++j) { const unsigned c = xb_ld(&bar[XB_XCNT(j)]); sum += c; cnt += (c > 0u) ? 1u : 0u; mine = (j == x) ? c : mine; }
        if (sum == G) break;
        __builtin_amdgcn_s_sleep(1);
        if ((++sp & 255u) == 0u) { if (xb_ld(&bar[XB_TMO])) break; if (sp > XB_SPIN_CAP) { atomicAdd(&bar[XB_TMO], 1u); break; } }
    }
    nloc = mine > 0u ? mine : 1u; nx = cnt > 0u ? cnt : 1u;
}
__device__ __forceinline__ void xcd_barrier(const XcdBarrier& b) {
    asm volatile("s_waitcnt vmcnt(0)" ::: "memory");
    __syncthreads();
    if (threadIdx.x == 0) {
        unsigned* bar = b.bar;
        __builtin_amdgcn_s_waitcnt(0);
        unsigned nloc = b.st[0], nx = b.st[1];
        if (nloc == 0u) { xcd_barrier_complete(bar, b.x, nloc, nx); b.st[0] = nloc; b.st[1] = nx; }
        const unsigned old = xb_add(&bar[XB_XSUB(b.x)], 1u);
        const unsigned gen = old / nloc;
        if (old + 1u == (gen + 1u) * nloc) {
            __builtin_amdgcn_fence(__ATOMIC_RELEASE, "agent");
            asm volatile("s_waitcnt vmcnt(0)" ::: "memory");
            const unsigned og = xb_add(&bar[XB_TOP], 1u);
            const unsigned tg = og / nx;
            if (og + 1u == (tg + 1u) * nx) xb_add(&bar[XB_TOPGEN], 1u);
            else XB_SPIN(xb_ld(&bar[XB_TOPGEN]) == tg, bar);
            __builtin_amdgcn_fence(__ATOMIC_ACQUIRE, "agent");
            xb_add(&bar[XB_XGEN(b.x)], 1u);
            asm volatile("s_waitcnt vmcnt(0)" ::: "memory");
        } else {
            XB_SPIN(xb_ld(&bar[XB_XGEN(b.x)]) == gen, bar);
            __builtin_amdgcn_fence(__ATOMIC_ACQUIRE, "agent");
            asm volatile("s_waitcnt vmcnt(0)" ::: "memory");
        }
    }
    __syncthreads();
}
__device__ __forceinline__ f32x4 part_sum(const float* part, int s0, int ns, int rl, int c) {
    f32x4 a = *(const f32x4*)(part + ((size_t)s0 * 256 + rl) * DM + c);
    for (int s = 1; s < ns; ++s) a += *(const f32x4*)(part + ((size_t)(s0 + s) * 256 + rl) * DM + c);
    return a;
}
__device__ __forceinline__ void ssq_store(float* ssq, const f32x4 x, int r, int t) {
    const float ss = row16_sum(x[0] * x[0] + x[1] * x[1] + x[2] * x[2] + x[3] * x[3]);
    if ((t & 15) == 0) ssq[((size_t)(t >> 6) * MTOK + r) * 4 + ((t & 63) >> 4)] = ss;
}
#define CG_SYNC() do { asm volatile("s_waitcnt vmcnt(0) lgkmcnt(0)" ::: "memory"); grid.sync(); \
    __builtin_amdgcn_fence(__ATOMIC_ACQUIRE, "agent"); asm volatile("s_waitcnt vmcnt(0)" ::: "memory"); } while (0)
#define GRID_SYNC() xcd_barrier(xbar)
__global__ void __launch_bounds__(512) fwd_megakernel(Params Pk) {
    extern __shared__ __attribute__((aligned(16))) unsigned char smem_raw[];
    LAS unsigned char* lds = (LAS unsigned char*)smem_raw;
    cg::grid_group grid = cg::this_grid();
    volatile LAS unsigned* xst = (volatile LAS unsigned*)(lds + 131072);
    if (threadIdx.x == 0) { xst[0] = 0u; xst[1] = 0u; }
    __syncthreads();
    const XcdBarrier xbar = xcd_barrier_post((unsigned*)(fresh_params()->ws + XBAR), xst);
#if (PHMASK >> 0) & 1
    { PP P = fresh_params(); char* ws = P->ws; const int tid = threadIdx.x, lane = tid & 63, wid = __builtin_amdgcn_readfirstlane(tid >> 6); Sched S; (void)lane; (void)wid; (void)S; (void)ws;
    phase0(P, lds);
    if (P->out == nullptr) CG_SYNC();
    }
    GRID_SYNC();
#endif
#ifdef DUMP_OFF
    if (DUMP_AT == 1) { PP P = fresh_params(); const bf16_t* src = (const bf16_t*)(P->ws + DUMP_OFF); float* o = P->out + 16000000;
        for (size_t i = (size_t)blockIdx.x * 512 + threadIdx.x; i < DUMP_N; i += (size_t)gridDim.x * 512) o[i] = DUMP_F32 == 2 ? ((const float*)src)[(i >> 6) * 384 + DUMP_STRIDE * 64 + (i & 63)] : DUMP_F32 ? ((const float*)src)[i * DUMP_STRIDE] : bf2f(src[i * DUMP_STRIDE]);
        return; }
#endif
#if (PHMASK >> 1) & 1
    { PP P = fresh_params(); char* ws = P->ws; const int tid = threadIdx.x, lane = tid & 63, wid = __builtin_amdgcn_readfirstlane(tid >> 6); Sched S; (void)lane; (void)wid; (void)S; (void)ws;
    { S.init(MTOK, 9216, 2048, ws + HBUF, ws + WT_IN);
      EpiIn E{(bf16_t*)(ws + QB), (bf16_t*)(ws + KP), (bf16_t*)(ws + VP), (bf16_t*)(ws + KS), (bf16_t*)(ws + VS), (bf16_t*)((char*)P->out + O_COLS), (bf16_t*)(ws + GA), (bf16_t*)(ws + GR), P->out};
      gemm_phase(lds, opaque(2048), S, E);
      const int G_ = (int)gridDim.x, nfull = S.nwg % G_;
      if (nfull > 0) { if ((int)blockIdx.x >= nfull) phase0_late(P, blockIdx.x - nfull, G_ - nfull); }
      else phase0_late(P, blockIdx.x, G_); }
    }
    GRID_SYNC();
#endif
#ifdef DUMP_OFF
    if (DUMP_AT == 2) { PP P = fresh_params(); const bf16_t* src = (const bf16_t*)(P->ws + DUMP_OFF); float* o = P->out + 16000000;
        for (size_t i = (size_t)blockIdx.x * 512 + threadIdx.x; i < DUMP_N; i += (size_t)gridDim.x * 512) o[i] = DUMP_F32 == 2 ? ((const float*)src)[(i >> 6) * 384 + DUMP_STRIDE * 64 + (i & 63)] : DUMP_F32 ? ((const float*)src)[i * DUMP_STRIDE] : bf2f(src[i * DUMP_STRIDE]);
        return; }
#endif
#if (PHMASK >> 2) & 1
    { PP P = fresh_params(); char* ws = P->ws; const int tid = threadIdx.x, lane = tid & 63, wid = __builtin_amdgcn_readfirstlane(tid >> 6); Sched S; (void)lane; (void)wid; (void)S; (void)ws;
    lora_a_phase(P);
#ifndef NOATTN
    if (wid >= 2) { LAS bf16_t* vt = (LAS bf16_t*)(lds + (wid - 2) * VT_BYTES); const int npw = gridDim.x * 6;
        for (int job = blockIdx.x * 6 + (wid - 2); job < 2048 + 128; job += npw) attn_job(P, vt, job, lane); }
#endif
    }
    GRID_SYNC();
#endif
#ifdef DUMP_OFF
    if (DUMP_AT == 3) { PP P = fresh_params(); const bf16_t* src = (const bf16_t*)(P->ws + DUMP_OFF); float* o = P->out + 16000000;
        for (size_t i = (size_t)blockIdx.x * 512 + threadIdx.x; i < DUMP_N; i += (size_t)gridDim.x * 512) o[i] = DUMP_F32 == 2 ? ((const float*)src)[(i >> 6) * 384 + DUMP_STRIDE * 64 + (i & 63)] : DUMP_F32 ? ((const float*)src)[i * DUMP_STRIDE] : bf2f(src[i * DUMP_STRIDE]);
        return; }
#endif
#if (PHMASK >> 3) & 1
    { PP P = fresh_params(); char* ws = P->ws; const int tid = threadIdx.x, lane = tid & 63, wid = __builtin_amdgcn_readfirstlane(tid >> 6); Sched S; (void)lane; (void)wid; (void)S; (void)ws;
    { S.init(MTOK, 3072, 384, (char*)P->out + O_LORA_A, ws + WT_LORA);
      EpiLora E{(bf16_t*)(ws + LORA_OUT), P->in[12], P->in[14]};
      gemm_phase(lds, opaque(384), S, E); }
    }
    GRID_SYNC();
#endif
#ifdef DUMP_OFF
    if (DUMP_AT == 4) { PP P = fresh_params(); const bf16_t* src = (const bf16_t*)(P->ws + DUMP_OFF); float* o = P->out + 16000000;
        for (size_t i = (size_t)blockIdx.x * 512 + threadIdx.x; i < DUMP_N; i += (size_t)gridDim.x * 512) o[i] = DUMP_F32 == 2 ? ((const float*)src)[(i >> 6) * 384 + DUMP_STRIDE * 64 + (i & 63)] : DUMP_F32 ? ((const float*)src)[i * DUMP_STRIDE] : bf2f(src[i * DUMP_STRIDE]);
        return; }
#endif
#if (PHMASK >> 4) & 1
    { PP P = fresh_params(); char* ws = P->ws; const int tid = threadIdx.x, lane = tid & 63, wid = __builtin_amdgcn_readfirstlane(tid >> 6); Sched S; (void)lane; (void)wid; (void)S; (void)ws;
    {
        const int B = blockIdx.x, xcd = B & 7, slot = B >> 3, bh = xcd * 4 + (slot >> 3), rq8 = slot & 7, rowb = rq8 * 8 + (wid & 1) * 4 + (lane >> 4);
        const bool scanner = wid < 2 && slot < 32;
        f32x4 St = (f32x4){0.f, 0.f, 0.f, 0.f};
        const int pw = B * 4 + ((wid & 1) | ((wid & 4) >> 1)), npw = gridDim.x * 4;
        for (int s = 0; s < 10; ++s) {
            if (s == 0) {
                for (int ti = B * 8 + wid; ti < 1024 + 256; ti += (int)gridDim.x * 8) {
                    if (ti < 1024) { const int b = ti >> 9, t = ti & 511;
                        prep_token(P, b * 4096 + t, lane, (float*)(ws + SEG) + ((size_t)(b * 16) * 512 + t) * 384, (size_t)512 * 384); }
                    else { const int tj = ti - 1024, b = tj >> 3, t = tj & 7;
                        prep_token(P, MPR + tj, lane, (float*)(ws + SREC) + ((size_t)(b * 16) * 8 + t) * 384, (size_t)8 * 384); } }
            } else if (wid < 2) {
                if (scanner && s >= 1 && s <= 8) { const int j = s - 1; __builtin_amdgcn_s_setprio(3);
                    scan_seg((const float*)(ws + SEG + (size_t)(j & 1) * SEG_SZ) + (size_t)bh * 512 * 384, (LAS float*)(lds + wid * 49152), St,
                             (float*)(ws + YRAW) + (size_t)(j & 1) * 1048576 + (size_t)(bh * 8 + rq8) * 4096, rowb, (wid & 1) * 4 + (lane >> 4), lane);
                    if (s == 8) *(f32x4*)(P->out + O_WKVP + ((size_t)bh * 64 + rowb) * 64 + (lane & 15) * 4) = St; __builtin_amdgcn_s_setprio(0); }
            } else if (wid != 4 && wid != 5) {
                if (s >= 1 && s < 8) for (int ti = pw; ti < 1024; ti += npw) { const int b = ti >> 9, t = ti & 511;
                    prep_token(P, b * 4096 + s * 512 + t, lane, (float*)(ws + SEG + (size_t)(s & 1) * SEG_SZ) + ((size_t)(b * 16) * 512 + t) * 384, (size_t)512 * 384); }
                if (s == 1) for (int job = pw; job < 8192; job += npw) scan_sample_job(P, job, lane);
                if (s >= 2) { const int j = s - 2; const float* ring = (const float*)(ws + YRAW) + (size_t)(j & 1) * 1048576;
                    for (int ti = pw; ti < 1024; ti += npw) { const int b = ti >> 9, t = ti & 511, hd = lane >> 2, sub = lane & 3; f32x4 y[4];
#pragma unroll
                        for (int q = 0; q < 4; ++q) y[q] = *(const f32x4*)(ring + ((size_t)((b * 16 + hd) * 8 + sub * 2 + (q >> 1)) * 512 + t) * 8 + (q & 1) * 4);
                        post_token(P, b * 4096 + j * 512 + t, lane, y); } }
                if (s >= 2 && s <= 8) {
                    const int hidx = (wid & 1) | ((wid & 4) >> 1); LAS float* ctile = (LAS float*)(hidx < 3 ? lds + 98304 + hidx * 9216 : lds + 131104);
                    const int slot = (s - 2) * npw + pw, nslots = 7 * npw;
                    const int widx[7] = {26, 27, 24, 29, 22, 23, 28}; const size_t wdst[7] = {WT_UP, WT_DN, WT_OUT, WT_PG, WT_BA, WT_BR, WT_PP};
                    const int wk[7] = {2048, 8192, 2048, 2048, 1024, 1024, 256}, wn[7] = {8192, 2048, 2048, 2048, 2048, 2048, 2048};
#pragma unroll
                    for (int j = 0; j < 7; ++j) { ConvJob J; J.src = P->in[widx[j]]; J.dst = (bf16_t*)(ws + wdst[j]); J.K = wk[j]; J.N = wn[j]; J.nNt = wn[j] >> 5; J.ntile = (wk[j] >> 6) * J.nNt;
                        conv_wave_run(J, (slot + j * 1171) % nslots, nslots, lane, ctile); }
                }
                if (s == 2) for (int ti = pw; ti < 256; ti += npw) { const int b = ti >> 3, t = ti & 7, hd = lane >> 2, sub = lane & 3; f32x4 y[4];
#pragma unroll
                    for (int q = 0; q < 4; ++q) y[q] = *(const f32x4*)((const float*)(ws + YRAW_S) + ((size_t)((b * 16 + hd) * 16 + sub * 4 + q) * 8 + t) * 4);
                    post_token(P, MPR + ti, lane, y); }
            }
            GRID_SYNC();
        }
    }
    }
#endif
#ifdef DUMP_OFF
    if (DUMP_AT == 5) { PP P = fresh_params(); const bf16_t* src = (const bf16_t*)(P->ws + DUMP_OFF); float* o = P->out + 16000000;
        for (size_t i = (size_t)blockIdx.x * 512 + threadIdx.x; i < DUMP_N; i += (size_t)gridDim.x * 512) o[i] = DUMP_F32 == 2 ? ((const float*)src)[(i >> 6) * 384 + DUMP_STRIDE * 64 + (i & 63)] : DUMP_F32 ? ((const float*)src)[i * DUMP_STRIDE] : bf2f(src[i * DUMP_STRIDE]);
        return; }
#endif
#if (PHMASK >> 5) & 1
    { PP P = fresh_params(); char* ws = P->ws; const int tid = threadIdx.x, lane = tid & 63, wid = __builtin_amdgcn_readfirstlane(tid >> 6); Sched S; (void)lane; (void)wid; (void)S; (void)ws;
    { S.init(MTOK, 2048, 1024, ws + YA, ws + WT_BA); S.dual = 1; S.A1 = ws + YR; S.B1 = ws + WT_BR;
      EpiMix E{(const bf16_t*)(ws + GA), (const bf16_t*)(ws + GR), (bf16_t*)(ws + MIXED), P->out};
      S.set_tail(4); S.nosub = 1;
      gemm_phase(lds, opaque(1024), S, E);
      Sched S2; S2.init(MTOK, 2048, 1024, ws + YA, ws + WT_BA); S2.A1 = ws + YR; S2.B1 = ws + WT_BR; S2.set_tail(4); S2.ngem = 2; S2.tail_i = 0; S2.part = (float*)(ws + SEG);
      EpiNone E2{}; gemm_phase(lds, opaque(1024), S2, E2); }
    }
    GRID_SYNC();
    { PP P = fresh_params(); char* ws = P->ws; const int t = threadIdx.x, rl = blockIdx.x;
      if (rl < 256) { const int c = t * 4; const size_t o = (size_t)(MPR + rl) * DM + c; const float* part = (const float*)(ws + SEG);
        const f32x4 a0 = part_sum(part, 0, 4, rl, c), a1 = part_sum(part, 4, 4, rl, c);
        const f32x4 ga = unpack4(*(const u32x2*)((const bf16_t*)(ws + GA) + o)), gr = unpack4(*(const u32x2*)((const bf16_t*)(ws + GR) + o));
        *(u32x2*)((bf16_t*)(ws + MIXED) + o) = pack4(ga * a0 + gr * a1); }
    }
    GRID_SYNC();
#endif
#ifdef DUMP_OFF
    if (DUMP_AT == 6) { PP P = fresh_params(); const bf16_t* src = (const bf16_t*)(P->ws + DUMP_OFF); float* o = P->out + 16000000;
        for (size_t i = (size_t)blockIdx.x * 512 + threadIdx.x; i < DUMP_N; i += (size_t)gridDim.x * 512) o[i] = DUMP_F32 == 2 ? ((const float*)src)[(i >> 6) * 384 + DUMP_STRIDE * 64 + (i & 63)] : DUMP_F32 ? ((const float*)src)[i * DUMP_STRIDE] : bf2f(src[i * DUMP_STRIDE]);
        return; }
#endif
#if (PHMASK >> 6) & 1
    { PP P = fresh_params(); char* ws = P->ws; const int tid = threadIdx.x, lane = tid & 63, wid = __builtin_amdgcn_readfirstlane(tid >> 6); Sched S; (void)lane; (void)wid; (void)S; (void)ws;
    { S.init(MTOK, 2048, 2048, ws + MIXED, ws + WT_OUT);
      EpiOut E{P->in[0], P->in[1], P->in[25], (bf16_t*)(ws + X1), (float*)(ws + SSQ1), (bf16_t*)(ws + HN)};
      S.set_tail(8); S.part = (float*)(ws + YR);
      gemm_phase(lds, opaque(2048), S, E); }
    }
    GRID_SYNC();
    { PP P = fresh_params(); char* ws = P->ws; const int t = threadIdx.x, rl = blockIdx.x;
      if (rl < 256) { const int c = t * 4, r = MPR + rl; const size_t o = (size_t)r * DM + c;
        const f32x4 x = *(const f32x4*)(P->in[1] + (size_t)rl * DM + c) + part_sum((const float*)(ws + YR), 0, 8, rl, c);
        *(u32x2*)((bf16_t*)(ws + X1) + o) = pack4(x); *(u32x2*)((bf16_t*)(ws + HN) + o) = pack4(x * *(const f32x4*)(P->in[25] + c));
        ssq_store((float*)(ws + SSQ1), x, r, t); }
    }
    GRID_SYNC();
#endif
#ifdef DUMP_OFF
    if (DUMP_AT == 7) { PP P = fresh_params(); const bf16_t* src = (const bf16_t*)(P->ws + DUMP_OFF); float* o = P->out + 16000000;
        for (size_t i = (size_t)blockIdx.x * 512 + threadIdx.x; i < DUMP_N; i += (size_t)gridDim.x * 512) o[i] = DUMP_F32 == 2 ? ((const float*)src)[(i >> 6) * 384 + DUMP_STRIDE * 64 + (i & 63)] : DUMP_F32 ? ((const float*)src)[i * DUMP_STRIDE] : bf2f(src[i * DUMP_STRIDE]);
        return; }
#endif
#if (PHMASK >> 7) & 1
    { PP P = fresh_params(); char* ws = P->ws; const int tid = threadIdx.x, lane = tid & 63, wid = __builtin_amdgcn_readfirstlane(tid >> 6); Sched S; (void)lane; (void)wid; (void)S; (void)ws;
    { S.init(MTOK, 8192, 2048, ws + HN, ws + WT_UP); S.set_tail(4); S.part = (float*)(ws + R12);
      float* rsb = (float*)(ws + RSB) + (size_t)blockIdx.x * 2048;
      { const float* ssq = (const float*)(ws + SSQ1); Unit u;
        for (int i = 0; i < 8 && S.next(i, u); ++i) if (tid < 256) { const int r = u.pm * BM + tid; const f32x4* sp = (const f32x4*)ssq + r; f32x4 t = sp[0];
#pragma unroll
            for (int k = 1; k < 8; ++k) t += sp[(size_t)k * MTOK];
            rsb[i * 256 + tid] = rsqrtf((t[0] + t[1] + t[2] + t[3]) * (1.0f / 2048.0f) + 1e-6f); }
        asm volatile("s_waitcnt vmcnt(0)" ::: "memory"); __syncthreads(); }
      EpiUp E{rsb, (bf16_t*)P->out, (bf16_t*)(ws + ACTB)};
      gemm_phase(lds, opaque(2048), S, E); }
    }
    GRID_SYNC();
    { PP P = fresh_params(); char* ws = P->ws; const int t = threadIdx.x, rl = blockIdx.x;
      if (rl < 256) { const int r = MPR + rl; const float* ssq = (const float*)(ws + SSQ1); const float* part = (const float*)(ws + R12);
        float tq = 0.f;
#pragma unroll
        for (int k = 0; k < 8; ++k) { const f32x4 q = *((const f32x4*)ssq + (size_t)k * MTOK + r); tq += (q[0] + q[1]) + (q[2] + q[3]); }
        const float rs = rsqrtf(tq * (1.0f / 2048.0f) + 1e-6f);
        bf16_t* dst = (bf16_t*)(ws + ACTB) + (size_t)(r - ACT_SPLIT * BM) * 8192;
        for (int c = t * 4; c < 8192; c += 2048) { f32x4 a = *(const f32x4*)(part + (size_t)rl * 8192 + c);
#pragma unroll
            for (int sl = 1; sl < 4; ++sl) a += *(const f32x4*)(part + ((size_t)sl * 256 + rl) * 8192 + c);
#pragma unroll
            for (int j = 0; j < 4; ++j) { const float z = fmaxf(a[j] * rs, 0.f); a[j] = z * z; }
            *(u32x2*)(dst + c) = pack4(a); } }
    }
    GRID_SYNC();
#endif
#if (PHMASK >> 8) & 1
    { PP P = fresh_params(); char* ws = P->ws; const int tid = threadIdx.x, lane = tid & 63, wid = __builtin_amdgcn_readfirstlane(tid >> 6); Sched S; (void)lane; (void)wid; (void)S; (void)ws;
    { S.init(MTOK, 2048, 8192, P->out, ws + WT_DN); S.splitpm = ACT_SPLIT; S.A0b = ws + ACTB;
      EpiDown E{(const bf16_t*)(ws + X1), (bf16_t*)(ws + X2B)};
      S.set_tail(8); S.part = (float*)(ws + YR);
      gemm_phase(lds, opaque(8192), S, E);
      if (blockIdx.x >= 64) {
          Sched SP; SP.init(MTOK, 2048, 256, ws + PEB, ws + WT_PP); SP.G = gridDim.x - 64; SP.c = blockIdx.x - 64;
          EpiP E0{(bf16_t*)(ws + PBUF)}; gemm_phase(lds, opaque(256), SP, E0); } }
    }
    GRID_SYNC();
    { PP P = fresh_params(); char* ws = P->ws; const int t = threadIdx.x, rl = blockIdx.x;
      if (rl < 256) { const int c = t * 4; const size_t o = (size_t)(MPR + rl) * DM + c;
        const f32x4 x = unpack4(*(const u32x2*)((const bf16_t*)(ws + X1) + o)) + part_sum((const float*)(ws + YR), 0, 8, rl, c);
        *(u32x2*)((bf16_t*)(ws + X2B) + o) = pack4(x); }
    }
    GRID_SYNC();
#endif
#if (PHMASK >> 9) & 1
    { PP P = fresh_params(); char* ws = P->ws; const int tid = threadIdx.x, lane = tid & 63, wid = __builtin_amdgcn_readfirstlane(tid >> 6); Sched S; (void)lane; (void)wid; (void)S; (void)ws;
    {
      S.init(MTOK, 2048, 2048, ws + X2B, ws + WT_PG);
      EpiGate E{(const bf16_t*)(ws + X2B), (const bf16_t*)(ws + PBUF), P->out, (float*)(ws + SSQ2)};
      S.set_tail(8); S.part = (float*)(ws + YR);
      gemm_phase(lds, opaque(2048), S, E); }
    }
    GRID_SYNC();
    { PP P = fresh_params(); char* ws = P->ws; const int t = threadIdx.x, rl = blockIdx.x;
      if (rl < 256) { const int c = t * 4, r = MPR + rl; const size_t o = (size_t)r * DM + c; LAS float* red = (LAS float*)lds;
        const f32x4 a = part_sum((const float*)(ws + YR), 0, 8, rl, c), p = unpack4(*(const u32x2*)((const bf16_t*)(ws + PBUF) + o)); f32x4 x = unpack4(*(const u32x2*)((const bf16_t*)(ws + X2B) + o));
#pragma unroll
        for (int j = 0; j < 4; ++j) x[j] += sigmoidf_(a[j]) * p[j];
        const float ws_ = wave_sum(x[0] * x[0] + x[1] * x[1] + x[2] * x[2] + x[3] * x[3]);
        if ((t & 63) == 0) red[t >> 6] = ws_;
        __syncthreads();
        float tot = 0.f;
#pragma unroll
        for (int k = 0; k < 8; ++k) tot += red[k];
        const float rs = rsqrtf(tot * (1.0f / 2048.0f) + 1e-6f);
        *(f32x4*)(P->out + o) = x * rs * *(const f32x4*)(P->in[30] + c); }
      __syncthreads();
    }
#endif
#if (PHMASK >> 10) & 1
    { PP P = fresh_params(); char* ws = P->ws; const int tid = threadIdx.x, lane = tid & 63, wid = __builtin_amdgcn_readfirstlane(tid >> 6); Sched S; (void)lane; (void)wid; (void)S; (void)ws;
    { const float* gf = P->in[30]; const float* ssq = (const float*)(ws + SSQ2);
      for (int r = blockIdx.x * 8 + wid; r < MPR; r += gridDim.x * 8) {
          float t = lane < 32 ? ssq[((size_t)(lane >> 2) * MTOK + r) * 4 + (lane & 3)] : 0.f; t = wave_sum(t); const float rs = rsqrtf(t * (1.0f / 2048.0f) + 1e-6f);
          float* x = P->out + (size_t)r * DM;
#pragma unroll
          for (int i = 0; i < 8; ++i) { const f32x4 v = *(const f32x4*)(x + i * 256 + lane * 4), g = *(const f32x4*)(gf + i * 256 + lane * 4); *(f32x4*)(x + i * 256 + lane * 4) = v * rs * g; }
      } }
    }
#endif
}

extern "C" void kernel_launch(void* const* d_in, const int* in_sizes, int n_in, void* d_out, int out_size, void* d_ws, size_t ws_size, hipStream_t stream) {
    static int grid_blocks = 0;
    if (!grid_blocks) {
        int dev = 0, cus = 0, per_cu = 0;
        hipGetDevice(&dev);
        hipFuncSetAttribute((const void*)fwd_megakernel, hipFuncAttributeMaxDynamicSharedMemorySize, (int)LDS_BYTES);
        hipDeviceGetAttribute(&cus, hipDeviceAttributeMultiprocessorCount, dev);
        hipOccupancyMaxActiveBlocksPerMultiprocessor(&per_cu, fwd_megakernel, 512, LDS_BYTES);
        grid_blocks = cus * (per_cu > 0 ? 1 : 0);
        if (grid_blocks > 256) grid_blocks = 256;
        if (ws_size < WS_END) fprintf(stderr, "workspace too small: %zu < %zu\n", ws_size, (size_t)WS_END);
    }
    Params p{};
    for (int i = 0; i < 31; ++i) p.in[i] = (const float*)d_in[i];
    p.out = (float*)d_out; p.ws = (char*)d_ws;
    (void)hipMemsetAsync((char*)d_ws + XBAR, 0, XCD_BAR_WORDS * sizeof(unsigned), stream);
    void* args[] = {&p};
    hipError_t e = hipLaunchCooperativeKernel((const void*)fwd_megakernel, dim3(grid_blocks), dim3(512), args, LDS_BYTES, stream);
    if (e != hipSuccess) fprintf(stderr, "cooperative launch failed: %s (grid %d)\n", hipGetErrorString(e), grid_blocks);
}
```

```cpp
#include <hip/hip_runtime.h>
#include <hip/hip_cooperative_groups.h>
#include <cstdio>
namespace cg = cooperative_groups;

#define LAS __attribute__((address_space(3)))
typedef unsigned short bf16_t;
typedef short bf16x8 __attribute__((ext_vector_type(8)));
typedef float f32x4 __attribute__((ext_vector_type(4)));
typedef float f32x2 __attribute__((ext_vector_type(2)));
typedef unsigned u32x4 __attribute__((ext_vector_type(4)));
typedef unsigned u32x2 __attribute__((ext_vector_type(2)));

constexpr int BM = 256, BK = 64, HALF = 128, HTB = HALF * BK * 2, STAGE_BYTES = 8 * HTB, NXCD = 8, WGM = 8;
constexpr int MTOK = 8448, MPR = 8192, DM = 2048, RC = 3360, RCL = 3584;
constexpr size_t LDS_BYTES = 147456;

constexpr size_t WT_BA = 0, WT_BR = 4194304, WT_OUT = 8388608, WT_UP = 16777216, WT_DN = 50331648, WT_PP = 83886080, WT_PG = 84934656, WT_LORA = 93323264;
constexpr size_t R12 = 95682560;
constexpr size_t WT_IN = R12, HBUF = R12 + 37748736;
constexpr size_t LORA_OUT = R12, YA = R12 + 51904512;
constexpr size_t MIXED = R12, HN = R12 + 34603008, X2B = R12;
constexpr size_t R3 = 168034304;
constexpr size_t QB = R3, KP = R3 + 17301504, VP = KP + 4194304, KS = VP + 4194304, VS = KS + 2359296;
constexpr size_t YRAW = R3, SREC = R3 + 8388608, YRAW_S = SREC + 6291456;
constexpr size_t ACTB = R3, PBUF = R12 + 34603008;
constexpr size_t SEG = 198443008, SEG_SZ = 25165824;
constexpr size_t YR = 248774656;
constexpr size_t GA = 266076160, GR = 300679168, X1 = GA;
constexpr size_t SSQ1 = 335282176, SSQ2 = SSQ1 + 1081344, BON = SSQ2 + 1081344, PEB = BON + 1081344;
constexpr size_t XBAR = PEB + 4325376;
constexpr size_t RSB = XBAR + 16384;
constexpr size_t WS_END = RSB + 2097152;
constexpr size_t O_COLS = 0, O_LORA_A = 60555264;
constexpr size_t O_KWP = 17301504, O_VWP = 17367040, O_WKVP = 17432576, O_SHP = 17563648, O_KWS = 17570368, O_VWS = 18618944, O_WKVS = 19667520, O_SHS = 21764672;
constexpr int ACT_SPLIT = 15;

#ifndef PHMASK
#define PHMASK 0x7ff
#endif
struct Params { const float* in[31]; float* out; char* ws; };
typedef const Params __attribute__((address_space(4)))* PP;
__device__ __forceinline__ PP fresh_params() { PP p = (PP)__builtin_amdgcn_kernarg_segment_ptr(); asm volatile("" : "+s"(p)); return p; }
__device__ __forceinline__ int opaque(int k) { asm volatile("" : "+s"(k)); return k; }

typedef __bf16 bf16x2_t __attribute__((ext_vector_type(2)));
__device__ __forceinline__ unsigned cvt_pk_bf16(float lo, float hi) { f32x2 v = {lo, hi}; bf16x2_t b = __builtin_convertvector(v, bf16x2_t); return __builtin_bit_cast(unsigned, b); }
__device__ __forceinline__ float bf2f(unsigned short b) { return __uint_as_float(((unsigned)b) << 16); }
__device__ __forceinline__ float bflo(unsigned w) { return __uint_as_float(w << 16); }
__device__ __forceinline__ float bfhi(unsigned w) { return __uint_as_float(w & 0xffff0000u); }
__device__ __forceinline__ u32x2 pack4(f32x4 v) { u32x2 w; w.x = cvt_pk_bf16(v[0], v[1]); w.y = cvt_pk_bf16(v[2], v[3]); return w; }
__device__ __forceinline__ f32x4 unpack4(u32x2 w) { return (f32x4){bflo(w.x), bfhi(w.x), bflo(w.y), bfhi(w.y)}; }
__device__ __forceinline__ float sigmoidf_(float x) { return __builtin_amdgcn_rcpf(1.0f + __expf(-x)); }
__device__ __forceinline__ float wave_sum(float x) {
#pragma unroll
    for (int o = 1; o < 64; o <<= 1) x += __shfl_xor(x, o);
    return x;
}
__device__ __forceinline__ float dppf(float x, const int ctrl) { return x; }
#define DPP_ADD(x, ctrl) ((x) + __builtin_bit_cast(float, __builtin_amdgcn_update_dpp(0, __builtin_bit_cast(int, (x)), (ctrl), 0xF, 0xF, true)))
__device__ __forceinline__ float row16_sum(float x) {
    x = DPP_ADD(x, 0xB1); x = DPP_ADD(x, 0x4E); x = DPP_ADD(x, 0x141); x = DPP_ADD(x, 0x140); return x;
}

__host__ __device__ __forceinline__ int lds_byte(int r, int c) { const int st = (r >> 4) * 2 + (c >> 5), rr = r & 15, cc = c & 31, ob = rr * 64 + cc * 2; return st * 1024 + (ob ^ (((ob >> 9) & 1) << 5)); }
__host__ __device__ __forceinline__ void stage_rc(int b, int& R, int& C) { const int st = b / 1024, sb = b % 1024, swz = sb ^ (((sb >> 9) & 1) << 5); R = (st >> 1) * 16 + swz / 64; C = (st & 1) * 32 + (swz % 64) / 2; }

struct Unit { int pm, pn, sub, zero, ui, nt, part; const char* A; const char* B; };
struct Sched {
    int nM, nN, nwg, G, c, dual, splitpm, ntfull, tail, sk, ntslice; size_t tstep; float* part; int tail_i, partld, ngem, nosub;
    const char *A0, *A0b, *B0, *A1, *B1;
    __device__ __forceinline__ void init(int M, int N, int K, const void* A, const void* B) { nM = M / BM; nN = N / BM; nwg = nM * nN; G = gridDim.x; c = blockIdx.x; dual = 0; splitpm = 1 << 30; ntfull = K / BK; tail = 0; sk = 1; ntslice = 0; part = nullptr; ngem = 1; nosub = 0; tstep = (size_t)BM * K * 2; A0 = (const char*)A; A0b = A0; B0 = (const char*)B; A1 = A0; B1 = B0; }
    __device__ __forceinline__ void set_tail(int sk_) { tail = 1; sk = sk_; ntslice = ntfull / sk_; nM = 32; nwg = nM * nN; tail_i = (dual ? 2 : 1) * (nwg / G); partld = nN * BM; ngem = dual ? 2 : 1; }
    __device__ __forceinline__ bool next(int i, Unit& u) const {
        if (tail && i >= tail_i) {
            const int j = c, nsl = ngem * sk;
            if (nosub || i != tail_i || j >= nN * nsl) return false;
            const int sl = j / nN; u.pn = j % nN; u.pm = 32; u.sub = sl / sk; u.zero = 1; u.ui = i; u.nt = ntslice; u.part = sl;
            const size_t koff = (size_t)(sl % sk) * ntslice * BK * 2;
            const char* ab = u.sub ? A1 : (u.pm >= splitpm ? A0b - (size_t)splitpm * tstep : A0);
            u.A = ab + (size_t)u.pm * tstep + koff; u.B = (u.sub ? B1 : B0) + (size_t)u.pn * tstep + koff;
            return true;
        }
        const int ti = dual ? (i >> 1) : i;
        const long L = (long)ti * G + c; if (L >= nwg) return false;
        int wgid = (int)L; { const int q = nwg / NXCD, r = nwg % NXCD, xcd = wgid % NXCD, off = wgid / NXCD; wgid = (xcd < r ? xcd * (q + 1) : r * (q + 1) + (xcd - r) * q) + off; }
        const int nig = WGM * nN, gid = wgid / nig, fm = gid * WGM, gsz = (nM - fm) < WGM ? (nM - fm) : WGM;
        u.pm = fm + ((wgid % nig) % gsz); u.pn = (wgid % nig) / gsz;
        u.sub = dual ? (i & 1) : 0; u.zero = (u.sub == 0); u.ui = i; u.nt = ntfull; u.part = -1;
        const char* ab = u.sub ? A1 : (u.pm >= splitpm ? A0b - (size_t)splitpm * tstep : A0);
        u.A = ab + (size_t)u.pm * tstep; u.B = (u.sub ? B1 : B0) + (size_t)u.pn * tstep;
        return true;
    }
};

template <class Epi>
__device__ __forceinline__ void gemm_phase(LAS unsigned char* lds, const int K, const Sched& S, const Epi& E) {
    int tid = threadIdx.x; asm volatile("" : "+v"(tid));
    const int wid = __builtin_amdgcn_readfirstlane(tid >> 6), lane = tid & 63, wr = wid >> 2, wc = wid & 3, fr = lane & 15, fq = lane >> 4;
    unsigned voffA[2], voffB[2];
#pragma unroll
    for (int i = 0; i < 2; ++i) { int R, C; stage_rc(tid * 16 + i * 8192, R, C); voffA[i] = (unsigned)(R * K + C) * 2u;
        const int rho = R & 31, Rb = (R & ~31) + 8 * ((rho & 15) >> 2) + 4 * (rho >> 4) + (rho & 3); voffB[i] = (unsigned)(Rb * K + C) * 2u; }
    const size_t kstep = (size_t)(BK * 2);
    const size_t hstep = (size_t)HALF * K * 2;
    const unsigned ldsw = (unsigned)wid * 1024u;
    const int aoff = lds_byte(wr * 64 + fr, fq * 8), boff = lds_byte(wc * 32 + fr, fq * 8);
#define PG8_SA(b, h) (((b) * 2 + (h)) * HTB)
#define PG8_SB(b, h) ((4 + (b) * 2 + (h)) * HTB)
#define PG8_STAGE(bufoff, gbase, voff) do { _Pragma("unroll") for (int _i = 0; _i < 2; ++_i) \
        __builtin_amdgcn_global_load_lds((const unsigned*)((const char*)(gbase) + (voff)[_i]), (LAS unsigned*)(lds + (bufoff) + ldsw + _i * 8192), 16, 0, 0); } while (0)
#define PG8_LDA(dst, b, h) do { _Pragma("unroll") for (int m = 0; m < 4; ++m) _Pragma("unroll") for (int k = 0; k < 2; ++k) dst[m][k] = *(const LAS bf16x8*)(lds + PG8_SA(b, h) + aoff + m * 2048 + k * 1024); } while (0)
#define PG8_LDB(dst, b, h) do { _Pragma("unroll") for (int n = 0; n < 2; ++n) _Pragma("unroll") for (int k = 0; k < 2; ++k) dst[n][k] = *(const LAS bf16x8*)(lds + PG8_SB(b, h) + boff + n * 2048 + k * 1024); } while (0)
#define PG8_MMA(ai, bj, At, Bt) do { __builtin_amdgcn_s_setprio(1); _Pragma("unroll") for (int m = 0; m < 4; ++m) _Pragma("unroll") for (int n = 0; n < 2; ++n) _Pragma("unroll") for (int k = 0; k < 2; ++k) \
        acc[ai][bj][m][n] = __builtin_amdgcn_mfma_f32_16x16x32_bf16(Bt[n][k], At[m][k], acc[ai][bj][m][n], 0, 0, 0); __builtin_amdgcn_s_setprio(0); } while (0)
#define PG8_WAIT_V(n) asm volatile("s_waitcnt vmcnt(" #n ")" ::: "memory")
#define PG8_WAIT_L(n) asm volatile("s_waitcnt lgkmcnt(" #n ")" ::: "memory")
#define PG8_BAR __builtin_amdgcn_s_barrier()
#define PG8_SCHED __builtin_amdgcn_sched_barrier(0)
    Unit cur, nxt; int ui = 0;
    if (!S.next(0, cur)) return;
    f32x4 acc[2][2][4][2];
#pragma unroll
    for (int a = 0; a < 2; ++a)
#pragma unroll
        for (int b = 0; b < 2; ++b)
#pragma unroll
            for (int m = 0; m < 4; ++m)
#pragma unroll
                for (int n = 0; n < 2; ++n) acc[a][b][m][n] = (f32x4){0.f, 0.f, 0.f, 0.f};
    bf16x8 At[4][2], B0[2][2], B1[2][2];
    const char* cA = cur.A; const char* cB = cur.B;
    PG8_STAGE(PG8_SB(0, 0), cB, voffB); PG8_STAGE(PG8_SA(0, 0), cA, voffA); PG8_STAGE(PG8_SB(0, 1), cB + hstep, voffB); PG8_STAGE(PG8_SA(0, 1), cA + hstep, voffA);
    if (wr == 1) PG8_BAR;
    PG8_WAIT_V(4); PG8_BAR;
    PG8_STAGE(PG8_SB(1, 0), cB + kstep, voffB); PG8_STAGE(PG8_SA(1, 0), cA + kstep, voffA); PG8_STAGE(PG8_SB(1, 1), cB + hstep + kstep, voffB);
    PG8_WAIT_V(6); PG8_BAR;
    for (;;) {
        const bool has_next = S.next(ui + 1, nxt);
        const char* nA = has_next ? nxt.A : cA; const char* nB = has_next ? nxt.B : cB;
        const int nt = cur.nt;
        for (int t = 0; t < nt; t += 2) {
            const bool last = (t == nt - 2);
            const char* a1 = cA + (size_t)(t + 1) * kstep;
            const char* a2 = last ? nA : cA + (size_t)(t + 2) * kstep; const char* b2 = last ? nB : cB + (size_t)(t + 2) * kstep;
            const char* a3 = a2 + kstep; const char* b3 = b2 + kstep;
            PG8_LDB(B0, 0, 0); PG8_SCHED; PG8_LDA(At, 0, 0); PG8_STAGE(PG8_SA(1, 1), a1 + hstep, voffA);
            PG8_WAIT_L(8); PG8_BAR; PG8_WAIT_L(0); PG8_MMA(0, 0, At, B0); PG8_BAR; PG8_SCHED;
            PG8_LDB(B1, 0, 1); PG8_STAGE(PG8_SB(0, 0), b2, voffB);
            PG8_BAR; PG8_WAIT_L(0); PG8_MMA(0, 1, At, B1); PG8_BAR;
            PG8_LDA(At, 0, 1); PG8_STAGE(PG8_SA(0, 0), a2, voffA);
            PG8_BAR; PG8_WAIT_L(0); PG8_MMA(1, 0, At, B0); PG8_BAR; PG8_SCHED;
            PG8_STAGE(PG8_SB(0, 1), b2 + hstep, voffB);
            PG8_WAIT_V(6); PG8_BAR; PG8_MMA(1, 1, At, B1); PG8_BAR;
            PG8_LDB(B0, 1, 0); PG8_SCHED; PG8_LDA(At, 1, 0); PG8_STAGE(PG8_SA(0, 1), a2 + hstep, voffA);
            PG8_WAIT_L(8); PG8_BAR; PG8_WAIT_L(0); PG8_MMA(0, 0, At, B0); PG8_BAR; PG8_SCHED;
            PG8_LDB(B1, 1, 1); PG8_STAGE(PG8_SB(1, 0), b3, voffB);
            PG8_BAR; PG8_WAIT_L(0); PG8_MMA(0, 1, At, B1); PG8_BAR;
            PG8_LDA(At, 1, 1); PG8_STAGE(PG8_SA(1, 0), a3, voffA);
            PG8_BAR; PG8_WAIT_L(0); PG8_MMA(1, 0, At, B0); PG8_BAR; PG8_SCHED;
            PG8_STAGE(PG8_SB(1, 1), b3 + hstep, voffB);
            PG8_WAIT_V(6); PG8_BAR; PG8_MMA(1, 1, At, B1); PG8_BAR;
        }
        if (cur.part >= 0) {
            float* pp = S.part + (size_t)cur.part * 256 * Epi::PARTLD + (size_t)(wr * 64 + fr) * Epi::PARTLD + cur.pn * 256 + wc * 32 + 8 * fq;
#pragma unroll
            for (int ai = 0; ai < 2; ++ai)
#pragma unroll
                for (int m = 0; m < 4; ++m)
#pragma unroll
                    for (int bj = 0; bj < 2; ++bj)
#pragma unroll
                        for (int n = 0; n < 2; ++n)
                            *(f32x4*)(pp + (size_t)(ai * HALF + m * 16) * Epi::PARTLD + bj * HALF + n * 4) = acc[ai][bj][m][n];
        } else E(acc, cur, wr, wc, fr, fq);
        if (!has_next) break;
        if (nxt.zero) {
#pragma unroll
            for (int a = 0; a < 2; ++a)
#pragma unroll
                for (int b = 0; b < 2; ++b)
#pragma unroll
                    for (int m = 0; m < 4; ++m)
#pragma unroll
                        for (int n = 0; n < 2; ++n) acc[a][b][m][n] = (f32x4){0.f, 0.f, 0.f, 0.f};
        }
        cur = nxt; cA = nA; cB = nB; ++ui;
    }
    PG8_WAIT_V(0);
    if (wr == 0) PG8_BAR;
    PG8_BAR;
#undef PG8_SA
#undef PG8_SB
#undef PG8_STAGE
#undef PG8_LDA
#undef PG8_LDB
#undef PG8_MMA
#undef PG8_WAIT_V
#undef PG8_WAIT_L
#undef PG8_BAR
#undef PG8_SCHED
}

#define EPI_LOOP_BEGIN \
    _Pragma("unroll") for (int ai = 0; ai < 2; ++ai) _Pragma("unroll") for (int m = 0; m < 4; ++m) { \
        const int r = u.pm * BM + ai * HALF + wr * 64 + m * 16 + fr; \
        _Pragma("unroll") for (int bj = 0; bj < 2; ++bj) _Pragma("unroll") for (int n = 0; n < 2; ++n) { \
            const int cl = bj * HALF + wc * 32 + 8 * fq + 4 * n; f32x4& v = acc[ai][bj][m][n];
#define EPI_LOOP_END } if (m == 3) asm volatile("" ::: "memory"); }

struct EpiIn {
    static constexpr int PARTLD = 2048;
    bf16_t *qb, *kp, *vp, *ks, *vs, *colsb, *ga, *gr; float* out;
    __device__ __forceinline__ void operator()(f32x4 (&acc)[2][2][4][2], const Unit& u, int wr, int wc, int fr, int fq) const {
        const int pn = u.pn;
        if (pn < 4) {
            EPI_LOOP_BEGIN *(u32x2*)(qb + (size_t)r * 1024 + pn * 256 + cl) = pack4(v); EPI_LOOP_END
        } else if (pn < 6) {
            bf16_t* dp = pn == 4 ? kp : vp; bf16_t* ds = pn == 4 ? ks : vs;
            float* owp = out + (pn == 4 ? O_KWP : O_VWP); float* ows = out + (pn == 4 ? O_KWS : O_VWS);
            EPI_LOOP_BEGIN
                if (r < MPR) { *(u32x2*)(dp + (size_t)r * 256 + cl) = pack4(v); const int b = r >> 12, t = r & 4095; if (t >= 3968) *(f32x4*)(owp + (size_t)(b * 128 + t - 3968) * 256 + cl) = v; }
                else { const int rs = r - MPR, b = rs >> 3, t = rs & 7; *(u32x2*)(ds + (size_t)(b * 144 + 128 + t) * 256 + cl) = pack4(v); *(f32x4*)(ows + (size_t)(b * 128 + 120 + t) * 256 + cl) = v; }
            EPI_LOOP_END
        } else if (pn < 20) {
            EPI_LOOP_BEGIN
                const int c = (pn - 6) * 256 + cl;
                if (c < RC) {
                    *(u32x2*)(colsb + (size_t)r * RCL + c) = pack4(v);
                    if (r < MPR) { if ((r & 4095) == 4095) *(f32x4*)(out + O_SHP + (size_t)(r >> 12) * RC + c) = v; }
                    else { if (((r - MPR) & 7) == 7) *(f32x4*)(out + O_SHS + (size_t)((r - MPR) >> 3) * RC + c) = v; }
                }
            EPI_LOOP_END
        } else {
            bf16_t* g = pn < 28 ? ga : gr; const int pb = pn < 28 ? 20 : 28;
            EPI_LOOP_BEGIN
                f32x4 s; s[0] = sigmoidf_(v[0]); s[1] = sigmoidf_(v[1]); s[2] = sigmoidf_(v[2]); s[3] = sigmoidf_(v[3]);
                *(u32x2*)(g + (size_t)r * DM + (pn - pb) * 256 + cl) = pack4(s);
            EPI_LOOP_END
        }
    }
};
struct EpiLora {
    static constexpr int PARTLD = 2048;
    bf16_t* o; const float *w0, *a0;
    __device__ __forceinline__ void operator()(f32x4 (&acc)[2][2][4][2], const Unit& u, int wr, int wc, int fr, int fq) const {
        const int grp = u.pn >> 2;
        EPI_LOOP_BEGIN
            const int c = u.pn * 256 + cl; f32x4 s = v;
            if (grp == 0) { const f32x4 b = *(const f32x4*)(w0 + c); _Pragma("unroll") for (int j = 0; j < 4; ++j) s[j] = sigmoidf_(v[j] + b[j]) * 0.60653066f; }
            else if (grp == 1) { const f32x4 b = *(const f32x4*)(a0 + c - 1024); _Pragma("unroll") for (int j = 0; j < 4; ++j) s[j] = sigmoidf_(v[j] + b[j]); }
            *(u32x2*)(o + (size_t)r * 3072 + c) = pack4(s);
        EPI_LOOP_END
    }
};
struct EpiMix {
    static constexpr int PARTLD = 2048;
    const bf16_t *ga, *gr; bf16_t* mixed; float* dbg;
    __device__ __forceinline__ void operator()(f32x4 (&acc)[2][2][4][2], const Unit& u, int wr, int wc, int fr, int fq) const {
        if (u.sub == 0) {
            EPI_LOOP_BEGIN
                const size_t o = (size_t)r * DM + u.pn * 256 + cl; const f32x4 a = unpack4(*(const u32x2*)(ga + o)), b = unpack4(*(const u32x2*)(gr + o));
                _Pragma("unroll") for (int j = 0; j < 4; ++j) v[j] *= a[j] * __builtin_amdgcn_rcpf(b[j]);
            EPI_LOOP_END
        } else {
            EPI_LOOP_BEGIN
                const size_t o = (size_t)r * DM + u.pn * 256 + cl; const f32x4 b = unpack4(*(const u32x2*)(gr + o));
                *(u32x2*)(mixed + o) = pack4(v * b);
#ifdef PROD_DUMP
                if ((r & 15) == 0) *(f32x4*)(dbg + 16000000 + (size_t)(r >> 4) * DM + u.pn * 256 + cl) = v * b;
#endif
            EPI_LOOP_END
        }
    }
};
struct EpiOut {
    static constexpr int PARTLD = 2048;
    const float *xp, *xs, *gn; bf16_t* x1; float* ssq; bf16_t* hn;
    __device__ __forceinline__ void operator()(f32x4 (&acc)[2][2][4][2], const Unit& u, int wr, int wc, int fr, int fq) const {
#pragma unroll
        for (int ai = 0; ai < 2; ++ai)
#pragma unroll
            for (int m = 0; m < 4; ++m) {
                const int r = u.pm * BM + ai * HALF + wr * 64 + m * 16 + fr;
                const float* xr = r < MPR ? xp + (size_t)r * DM : xs + (size_t)(r - MPR) * DM; float ss = 0.f;
#pragma unroll
                for (int bj = 0; bj < 2; ++bj)
#pragma unroll
                    for (int n = 0; n < 2; ++n) {
                        const int c = u.pn * 256 + bj * HALF + wc * 32 + 8 * fq + 4 * n;
                        const f32x4 x = *(const f32x4*)(xr + c) + acc[ai][bj][m][n]; const f32x4 g = *(const f32x4*)(gn + c);
                        *(u32x2*)(x1 + (size_t)r * DM + c) = pack4(x); *(u32x2*)(hn + (size_t)r * DM + c) = pack4(x * g);
                        ss += x[0] * x[0] + x[1] * x[1] + x[2] * x[2] + x[3] * x[3];
                    }
                ss += __shfl_xor(ss, 16); ss += __shfl_xor(ss, 32);
                if (fq == 0) ssq[((size_t)u.pn * MTOK + r) * 4 + wc] = ss;
            }
    }
};
struct EpiUp {
    static constexpr int PARTLD = 8192;
    const float* rsb; bf16_t *actA, *actB;
    __device__ __forceinline__ void operator()(f32x4 (&acc)[2][2][4][2], const Unit& u, int wr, int wc, int fr, int fq) const {
        bf16_t* base = u.pm < ACT_SPLIT ? actA : actB - (size_t)ACT_SPLIT * BM * 8192;
        float rsv[2][4];
#pragma unroll
        for (int ai = 0; ai < 2; ++ai)
#pragma unroll
            for (int m = 0; m < 4; ++m) rsv[ai][m] = rsb[u.ui * 256 + ai * HALF + wr * 64 + m * 16 + fr];
#pragma unroll
        for (int ai = 0; ai < 2; ++ai)
#pragma unroll
            for (int m = 0; m < 4; ++m) {
                const int r = u.pm * BM + ai * HALF + wr * 64 + m * 16 + fr; const float rs = rsv[ai][m];
#pragma unroll
                for (int bj = 0; bj < 2; ++bj)
#pragma unroll
                    for (int n = 0; n < 2; ++n) {
                        const int c = u.pn * 256 + bj * HALF + wc * 32 + 8 * fq + 4 * n; f32x4 a = acc[ai][bj][m][n] * rs;
#pragma unroll
                        for (int j = 0; j < 4; ++j) { const float z = fmaxf(a[j], 0.f); a[j] = z * z; }
                        *(u32x2*)(base + (size_t)r * 8192 + c) = pack4(a);
                    }
            }
    }
};
struct EpiNone {
    static constexpr int PARTLD = 2048;
    __device__ __forceinline__ void operator()(f32x4 (&acc)[2][2][4][2], const Unit& u, int wr, int wc, int fr, int fq) const {}
};
struct EpiDown {
    static constexpr int PARTLD = 2048;
    const bf16_t* x1; bf16_t* x2b;
    __device__ __forceinline__ void operator()(f32x4 (&acc)[2][2][4][2], const Unit& u, int wr, int wc, int fr, int fq) const {
        EPI_LOOP_BEGIN
            const size_t o = (size_t)r * DM + u.pn * 256 + cl; const f32x4 x = unpack4(*(const u32x2*)(x1 + o)) + v;
            *(u32x2*)(x2b + o) = pack4(x);
        EPI_LOOP_END
    }
};
struct EpiP {
    static constexpr int PARTLD = 2048;
    bf16_t* pb;
    __device__ __forceinline__ void operator()(f32x4 (&acc)[2][2][4][2], const Unit& u, int wr, int wc, int fr, int fq) const {
        EPI_LOOP_BEGIN *(u32x2*)(pb + (size_t)r * DM + u.pn * 256 + cl) = pack4(v); EPI_LOOP_END
    }
};
struct EpiGate {
    static constexpr int PARTLD = 2048;
    const bf16_t* x2; const bf16_t* pb; bf16_t* o; float* ssq;
    __device__ __forceinline__ void operator()(f32x4 (&acc)[2][2][4][2], const Unit& u, int wr, int wc, int fr, int fq) const {
#pragma unroll
        for (int ai = 0; ai < 2; ++ai)
#pragma unroll
            for (int m = 0; m < 4; ++m) {
                const int r = u.pm * BM + ai * HALF + wr * 64 + m * 16 + fr; float ss = 0.f;
#pragma unroll
                for (int bj = 0; bj < 2; ++bj)
#pragma unroll
                    for (int n = 0; n < 2; ++n) {
                        const size_t of = (size_t)r * DM + u.pn * 256 + bj * HALF + wc * 32 + 8 * fq + 4 * n;
                        const f32x4 a = acc[ai][bj][m][n], p = unpack4(*(const u32x2*)(pb + of)); f32x4 x = unpack4(*(const u32x2*)(x2 + of));
#pragma unroll
                        for (int j = 0; j < 4; ++j) x[j] += sigmoidf_(a[j]) * p[j];
                        *(u32x2*)(o + of) = pack4(x); ss += x[0] * x[0] + x[1] * x[1] + x[2] * x[2] + x[3] * x[3];
                    }
                ss += __shfl_xor(ss, 16); ss += __shfl_xor(ss, 32);
                if (fq == 0) ssq[((size_t)u.pn * MTOK + r) * 4 + wc] = ss;
            }
    }
};

__device__ __forceinline__ void conv_t(LAS float* tile, const float* __restrict__ src, int K, int N, bf16_t* dst, int gap_at, int gap) {
    const int tid = threadIdx.x, nNt = (N + 127) >> 7, ntile = (K >> 6) * nNt;
    for (int t = blockIdx.x; t < ntile; t += gridDim.x) {
        const int k0 = (t / nNt) << 6, n0 = (t % nNt) << 7;
        const int row = tid >> 5, c4 = (tid & 31) << 2, n = n0 + c4;
        f32x4 v[4];
#pragma unroll
        for (int rr = 0; rr < 4; ++rr) { v[rr] = (f32x4){0.f, 0.f, 0.f, 0.f}; if (n < N) v[rr] = *(const f32x4*)(src + (size_t)(k0 + row + rr * 16) * N + n); }
#pragma unroll
        for (int rr = 0; rr < 4; ++rr)
#pragma unroll
            for (int i = 0; i < 4; ++i) tile[(row + rr * 16) * 129 + c4 + i] = v[rr][i];
        __syncthreads();
        const int kk = (tid & 7) << 3;
#pragma unroll
        for (int h = 0; h < 2; ++h) { const int nn = (tid >> 3) + h * 64, nq = n0 + nn;
            if (nq < N) {
                const int np = nq + (nq >= gap_at ? gap : 0); u32x4 w;
                w.x = cvt_pk_bf16(tile[(kk + 0) * 129 + nn], tile[(kk + 1) * 129 + nn]); w.y = cvt_pk_bf16(tile[(kk + 2) * 129 + nn], tile[(kk + 3) * 129 + nn]);
                w.z = cvt_pk_bf16(tile[(kk + 4) * 129 + nn], tile[(kk + 5) * 129 + nn]); w.w = cvt_pk_bf16(tile[(kk + 6) * 129 + nn], tile[(kk + 7) * 129 + nn]);
                *(u32x4*)(dst + (size_t)np * K + k0 + kk) = w;
            } }
        __syncthreads();
    }
}

struct ConvJob { const float* src; bf16_t* dst; int K, N, nNt, ntile; };
__device__ __forceinline__ void conv_wave_load(const ConvJob& J, int t, int lane, f32x4 (&v)[8]) {
    const int k0 = (t / J.nNt) << 6, n0 = (t % J.nNt) << 5;
    const float* p = J.src + (size_t)(k0 + (lane >> 3)) * J.N + n0 + ((lane & 7) << 2);
#pragma unroll
    for (int i = 0; i < 8; ++i) v[i] = *(const f32x4*)(p + (size_t)(i * 8) * J.N);
}
__device__ __forceinline__ void conv_wave_store(const ConvJob& J, int t, int lane, const f32x4 (&v)[8], LAS float* tile) {
    const int k0 = (t / J.nNt) << 6, n0 = (t % J.nNt) << 5;
#pragma unroll
    for (int i = 0; i < 8; ++i) *(LAS f32x4*)(tile + ((lane >> 3) + i * 8) * 36 + ((lane & 7) << 2)) = v[i];
    const int nn = lane >> 1, kh = (lane & 1) << 5;
    u32x4 w[4];
#pragma unroll
    for (int j = 0; j < 4; ++j) { const LAS float* tp = tile + (kh + j * 8) * 36 + nn;
        w[j].x = cvt_pk_bf16(tp[0], tp[36]); w[j].y = cvt_pk_bf16(tp[72], tp[108]); w[j].z = cvt_pk_bf16(tp[144], tp[180]); w[j].w = cvt_pk_bf16(tp[216], tp[252]); }
    bf16_t* d = J.dst + (size_t)(n0 + nn) * J.K + k0 + kh;
#pragma unroll
    for (int j = 0; j < 4; ++j) *(u32x4*)(d + j * 8) = w[j];
}
__device__ __forceinline__ void conv_wave_run(const ConvJob& J, int slot, int nslots, int lane, LAS float* tile) {
    f32x4 v[8];
    for (int t = slot; t < J.ntile; t += nslots) { conv_wave_load(J, t, lane, v); conv_wave_store(J, t, lane, v, tile); }
}
__device__ __forceinline__ void phase0(PP P, LAS unsigned char* lds) {
    char* ws = P->ws; const int tid = threadIdx.x, lane = tid & 63, wid = tid >> 6;
    const size_t gtid = (size_t)blockIdx.x * 512 + tid, gsz = (size_t)gridDim.x * 512;
    LAS float* tile = (LAS float*)lds;
    conv_t(tile, P->in[9], 2048, 8992, (bf16_t*)(ws + WT_IN), 4896, 224);
    { u32x4* z = (u32x4*)(ws + WT_IN + (size_t)4896 * 2048 * 2); for (size_t i = gtid; i < (size_t)224 * 2048 * 2 / 16; i += gsz) z[i] = (u32x4){0u, 0u, 0u, 0u}; }
    { const float* gm = P->in[8]; bf16_t* h = (bf16_t*)(ws + HBUF);
      for (int r = blockIdx.x * 8 + wid; r < MTOK; r += gridDim.x * 8) {
          const float* x = r < MPR ? P->in[0] + (size_t)r * DM : P->in[1] + (size_t)(r - MPR) * DM; f32x4 v[8]; float ss = 0.f;
#pragma unroll
          for (int i = 0; i < 8; ++i) { v[i] = *(const f32x4*)(x + i * 256 + lane * 4); ss += v[i][0] * v[i][0] + v[i][1] * v[i][1] + v[i][2] * v[i][2] + v[i][3] * v[i][3]; }
          ss = wave_sum(ss); const float rs = rsqrtf(ss * (1.0f / 2048.0f) + 1e-6f);
#pragma unroll
          for (int i = 0; i < 8; ++i) { const f32x4 g = *(const f32x4*)(gm + i * 256 + lane * 4); *(u32x2*)(h + (size_t)r * DM + i * 256 + lane * 4) = pack4(v[i] * rs * g); }
      } }
}

__device__ __forceinline__ void phase0_late(PP P, int bidx, int nblk) {
    char* ws = P->ws; const int tid = threadIdx.x;
    const size_t gtid = (size_t)bidx * 512 + tid, gsz = (size_t)nblk * 512;
    { bf16_t* L = (bf16_t*)(ws + WT_LORA); const float *w2 = P->in[13], *a2 = P->in[15], *g2 = P->in[16];
      for (size_t i = gtid; i < (size_t)3072 * 384; i += gsz) { const int n = (int)(i / 384), k = (int)(i % 384); float v = 0.f;
          if (n < 1024) { if (k < 64) v = w2[k * 1024 + n]; } else if (n < 2048) { if (k >= 64 && k < 128) v = a2[(k - 64) * 1024 + n - 1024]; } else { if (k >= 128 && k < 288) v = g2[(k - 128) * 1024 + n - 2048]; }
          L[i] = (bf16_t)(cvt_pk_bf16(v, 0.f) & 0xffffu); } }
    { bf16_t* pb = (bf16_t*)(ws + PEB);
      for (size_t i = gtid; i < (size_t)MTOK * 64; i += gsz) { const size_t e = i * 4; const float* s = e < (size_t)MPR * 256 ? P->in[6] + e : P->in[7] + (e - (size_t)MPR * 256); *(u32x2*)(pb + e) = pack4(*(const f32x4*)s); } }
    { bf16_t *ks = (bf16_t*)(ws + KS), *vs = (bf16_t*)(ws + VS);
      for (size_t i = gtid; i < (size_t)32 * 144 * 64; i += gsz) { const int b = (int)(i / (144 * 64)), rem = (int)(i % (144 * 64)), key = rem >> 6, c = (rem & 63) << 2;
          if (key >= 128 && key < 136) continue;
          f32x4 kv = (f32x4){0.f, 0.f, 0.f, 0.f}, vv = kv;
          if (key < 128) { kv = *(const f32x4*)(P->in[2] + ((size_t)b * 128 + key) * 256 + c); vv = *(const f32x4*)(P->in[3] + ((size_t)b * 128 + key) * 256 + c);
              if (key >= 8) { *(f32x4*)(P->out + O_KWS + ((size_t)b * 128 + key - 8) * 256 + c) = kv; *(f32x4*)(P->out + O_VWS + ((size_t)b * 128 + key - 8) * 256 + c) = vv; } }
          *(u32x2*)(ks + ((size_t)b * 144 + key) * 256 + c) = pack4(kv); *(u32x2*)(vs + ((size_t)b * 144 + key) * 256 + c) = pack4(vv); } }
}

constexpr int VT_STRIDE = 168, VT_BYTES = 64 * VT_STRIDE * 2;
__device__ __forceinline__ void attn_job(PP P, LAS bf16_t* vt, int job, int lane) {
    char* ws = P->ws; const int fr = lane & 15, fq = lane >> 4;
    const bool smp = job >= 2048; int b, kvh, q0;
    if (!smp) { const int qt = job >> 2; kvh = job & 3; b = qt >> 8; q0 = (qt & 255) << 4; } else { const int js = job - 2048; b = js >> 2; kvh = js & 3; q0 = 128; }
    const bf16_t* kbase = smp ? (const bf16_t*)(ws + KS) + (size_t)b * 144 * 256 : (const bf16_t*)(ws + KP) + ((size_t)b * 4096 + q0 - 128) * 256;
    const bf16_t* vbase = smp ? (const bf16_t*)(ws + VS) + (size_t)b * 144 * 256 : (const bf16_t*)(ws + VP) + ((size_t)b * 4096 + q0 - 128) * 256;
    const int jmin = smp ? 0 : (128 - q0 > 0 ? 128 - q0 : 0);
    for (int i = lane; i < 160 * 8; i += 64) { const int j = i >> 3, c8 = i & 7; u32x4 w = (u32x4){0u, 0u, 0u, 0u};
        if (j >= jmin && j < 144) w = *(const u32x4*)(vbase + (size_t)j * 256 + kvh * 64 + c8 * 8);
        LAS bf16_t* d = vt + (c8 * 8) * VT_STRIDE + j;
        d[0] = (bf16_t)(w.x & 0xffff); d[VT_STRIDE] = (bf16_t)(w.x >> 16); d[2 * VT_STRIDE] = (bf16_t)(w.y & 0xffff); d[3 * VT_STRIDE] = (bf16_t)(w.y >> 16);
        d[4 * VT_STRIDE] = (bf16_t)(w.z & 0xffff); d[5 * VT_STRIDE] = (bf16_t)(w.z >> 16); d[6 * VT_STRIDE] = (bf16_t)(w.w & 0xffff); d[7 * VT_STRIDE] = (bf16_t)(w.w >> 16); }
    const bf16_t* qrow = (const bf16_t*)(ws + QB) + (smp ? (size_t)(MPR + b * 8 + (fr & 7)) : (size_t)(b * 4096 + q0 + fr)) * 1024;
    bf16_t* orow = (bf16_t*)(ws + YA) + (smp ? (size_t)(MPR + b * 8 + (fr & 7)) : (size_t)(b * 4096 + q0 + fr)) * 1024;
    for (int g = 0; g < 4; ++g) {
        const int hd = kvh * 4 + g; const float slope = exp2f(-0.5f * (float)(hd + 1)), sink = P->in[10][hd];
        const bf16x8 q0f = *(const bf16x8*)(qrow + hd * 64 + fq * 8), q1f = *(const bf16x8*)(qrow + hd * 64 + 32 + fq * 8);
        f32x4 s[9]; float mx = -1e30f;
#pragma unroll
        for (int kt = 0; kt < 9; ++kt) {
            if (kt % 3 == 0) asm volatile("" ::: "memory");
            bf16x8 k0f = (bf16x8){0, 0, 0, 0, 0, 0, 0, 0}, k1f = k0f;
            { const int jk = kt * 16 + fr; if (jk >= jmin) { const bf16_t* kp_ = kbase + (size_t)jk * 256 + kvh * 64 + fq * 8; k0f = *(const bf16x8*)kp_; k1f = *(const bf16x8*)(kp_ + 32); } }
            f32x4 a = __builtin_amdgcn_mfma_f32_16x16x32_bf16(k0f, q0f, (f32x4){0.f, 0.f, 0.f, 0.f}, 0, 0, 0);
            a = __builtin_amdgcn_mfma_f32_16x16x32_bf16(k1f, q1f, a, 0, 0, 0);
#pragma unroll
            for (int j = 0; j < 4; ++j) { const int jp = kt * 16 + fq * 4 + j, dist = 128 + fr - jp; const bool ok = dist >= 0 && dist <= 128 && jp >= jmin;
                a[j] = ok ? a[j] * 0.125f - slope * (float)dist : -1e30f; mx = fmaxf(mx, a[j]); }
            s[kt] = a;
        }
        mx = fmaxf(mx, __shfl_xor(mx, 16)); mx = fmaxf(mx, __shfl_xor(mx, 32));
        const float mm = fmaxf(mx, sink); float sum = 0.f;
#pragma unroll
        for (int kt = 0; kt < 9; ++kt)
#pragma unroll
            for (int j = 0; j < 4; ++j) { const float p = s[kt][j] > -1e29f ? __expf(s[kt][j] - mm) : 0.f; s[kt][j] = p; sum += p; }
        sum += __shfl_xor(sum, 16); sum += __shfl_xor(sum, 32);
        const float inv = 1.0f / (sum + __expf(sink - mm));
        f32x4 o[4];
#pragma unroll
        for (int dt = 0; dt < 4; ++dt) o[dt] = (f32x4){0.f, 0.f, 0.f, 0.f};
#pragma unroll
        for (int pp = 0; pp < 5; ++pp) {
            const f32x4 p0 = s[2 * pp] * inv; f32x4 p1 = (f32x4){0.f, 0.f, 0.f, 0.f}; if (pp < 4) p1 = s[2 * pp + 1] * inv;
            u32x4 pw; pw.x = cvt_pk_bf16(p0[0], p0[1]); pw.y = cvt_pk_bf16(p0[2], p0[3]); pw.z = cvt_pk_bf16(p1[0], p1[1]); pw.w = cvt_pk_bf16(p1[2], p1[3]);
            const bf16x8 pb = __builtin_bit_cast(bf16x8, pw);
#pragma unroll
            for (int dt = 0; dt < 4; ++dt) {
                const LAS bf16_t* vp = vt + (dt * 16 + fr) * VT_STRIDE + pp * 32 + fq * 4;
                u32x4 vw; const u32x2 lo = *(const LAS u32x2*)vp, hi = *(const LAS u32x2*)(vp + 16); vw.x = lo.x; vw.y = lo.y; vw.z = hi.x; vw.w = hi.y;
                o[dt] = __builtin_amdgcn_mfma_f32_16x16x32_bf16(__builtin_bit_cast(bf16x8, vw), pb, o[dt], 0, 0, 0);
            }
        }
        if (!smp || fr < 8) {
#pragma unroll
            for (int dt = 0; dt < 4; ++dt) *(u32x2*)(orow + hd * 64 + dt * 16 + fq * 4) = pack4(o[dt]);
        }
    }
}

__device__ __forceinline__ float xx_col(PP P, const bf16_t* cols, int r, int col) {
    const float c = bf2f(cols[(size_t)r * RCL + col]); float p;
    if (r < MPR) p = (r & 4095) == 0 ? 0.f : bf2f(cols[(size_t)(r - 1) * RCL + col]);
    else { const int rs = r - MPR; p = (rs & 7) == 0 ? P->in[5][(size_t)(rs >> 3) * RC + col] : bf2f(cols[(size_t)(r - 1) * RCL + col]); }
    return c + (p - c) * P->in[11][col];
}
__device__ __forceinline__ void lora_a_phase(PP P) {
    const bf16_t* cols = (const bf16_t*)((const char*)P->out + O_COLS); bf16_t* A = (bf16_t*)((char*)P->out + O_LORA_A);
    const size_t gtid = (size_t)blockIdx.x * 512 + threadIdx.x, gsz = (size_t)gridDim.x * 512;
    for (size_t i = gtid; i < (size_t)MTOK * 96; i += gsz) { const int r = (int)(i / 96), j4 = (int)(i % 96) * 4; f32x4 v = (f32x4){0.f, 0.f, 0.f, 0.f};
        if (j4 < 288) {
#pragma unroll
            for (int j = 0; j < 4; ++j) { const float x = xx_col(P, cols, r, 3072 + j4 + j); v[j] = j4 < 64 ? tanhf(x) : (j4 < 128 ? x : sigmoidf_(x)); } }
        *(u32x2*)(A + (size_t)r * 384 + j4) = pack4(v); }
}
__device__ __forceinline__ f32x4 ld4bf(const bf16_t* p) { return unpack4(*(const u32x2*)p); }
__device__ __forceinline__ f32x4 xx4(PP P, const bf16_t* cols, int r, int col) {
    const f32x4 c = ld4bf(cols + (size_t)r * RCL + col); f32x4 p = (f32x4){0.f, 0.f, 0.f, 0.f};
    if (r < MPR) { if ((r & 4095) != 0) p = ld4bf(cols + (size_t)(r - 1) * RCL + col); }
    else { const int rs = r - MPR; if ((rs & 7) == 0) p = *(const f32x4*)(P->in[5] + (size_t)(rs >> 3) * RC + col); else p = ld4bf(cols + (size_t)(r - 1) * RCL + col); }
    return c + (p - c) * *(const f32x4*)(P->in[11] + col);
}
__device__ __forceinline__ float quad_sum(float x) { x = DPP_ADD(x, 0xB1); x = DPP_ADD(x, 0x4E); return x; }
__device__ __forceinline__ float hsum4(f32x4 v) { return (v[0] + v[1]) + (v[2] + v[3]); }
__device__ __forceinline__ void prep_token(PP P, int r, int lane, float* rec0, size_t hstride) {
    const bf16_t* cols = (const bf16_t*)((const char*)P->out + O_COLS); const bf16_t* lo = (const bf16_t*)(P->ws + LORA_OUT) + (size_t)r * 3072;
    const int hd = lane >> 2, sub = lane & 3, ch0 = lane * 16;
    float ss = 0.f, bon = 0.f;
#pragma unroll 1
    for (int q = 0; q < 4; ++q) { const int c = ch0 + q * 4;
        const f32x4 xr = xx4(P, cols, r, c), xk = xx4(P, cols, r, 1024 + c), a = ld4bf(lo + 1024 + c);
        const f32x4 kk = xk * *(const f32x4*)(P->in[17] + c); ss += hsum4(kk * kk);
        const f32x4 k32 = xk * (1.0f + (a - 1.0f) * *(const f32x4*)(P->in[18] + c));
        bon += hsum4(xr * k32 * *(const f32x4*)(P->in[19] + c)); }
    ss = quad_sum(ss); bon = quad_sum(bon);
    const float inv = rsqrtf(fmaxf(ss, 1e-24f));
    if (sub == 0) ((float*)(P->ws + BON))[(size_t)r * 32 + hd] = bon;
    float* rec = rec0 + (size_t)hd * hstride + sub * 16;
#pragma unroll 1
    for (int q = 0; q < 4; ++q) { const int c = ch0 + q * 4;
        const f32x4 xr = xx4(P, cols, r, c), xk = xx4(P, cols, r, 1024 + c), xv = xx4(P, cols, r, 2048 + c), e = ld4bf(lo + c), a = ld4bf(lo + 1024 + c);
        const f32x4 kn = xk * *(const f32x4*)(P->in[17] + c) * inv;
        const f32x4 k32 = xk * (1.0f + (a - 1.0f) * *(const f32x4*)(P->in[18] + c));
        f32x4 w;
#pragma unroll
        for (int j = 0; j < 4; ++j) w[j] = __expf(-e[j]);
        *(f32x4*)(rec + q * 4) = -kn; *(f32x4*)(rec + 64 + q * 4) = w; *(f32x4*)(rec + 128 + q * 4) = kn * a;
        *(f32x4*)(rec + 192 + q * 4) = k32; *(f32x4*)(rec + 256 + q * 4) = xr; *(f32x4*)(rec + 320 + q * 4) = xv; }
}
__device__ __forceinline__ void post_token(PP P, int r, int lane, const f32x4 (&y)[4]) {
    const bf16_t* cols = (const bf16_t*)((const char*)P->out + O_COLS); const bf16_t* lo = (const bf16_t*)(P->ws + LORA_OUT) + (size_t)r * 3072;
    const int hd = lane >> 2, ch0 = lane * 16;
    const float mean = quad_sum(hsum4(y[0]) + hsum4(y[1]) + hsum4(y[2]) + hsum4(y[3])) * (1.0f / 64.0f);
    float vs = 0.f;
#pragma unroll
    for (int q = 0; q < 4; ++q) { const f32x4 d = y[q] - mean; vs += hsum4(d * d); }
    const float rstd = rsqrtf(quad_sum(vs) * (1.0f / 64.0f) + 64e-5f), bon = ((const float*)(P->ws + BON))[(size_t)r * 32 + hd];
#pragma unroll
    for (int q = 0; q < 4; ++q) { const int c = ch0 + q * 4;
        f32x4 yn = (y[q] - mean) * rstd * *(const f32x4*)(P->in[20] + c) + *(const f32x4*)(P->in[21] + c);
        yn += bon * xx4(P, cols, r, 2048 + c);
        *(u32x2*)((bf16_t*)(P->ws + YR) + (size_t)r * 1024 + c) = pack4(yn * ld4bf(lo + 2048 + c)); }
}
struct StepOps { f32x4 nk, w, ka, k, r; float vv; };
__device__ __forceinline__ float wkv_step(f32x4& S, const StepOps& o) {
    f32x2 s01 = {S[0], S[1]}, s23 = {S[2], S[3]};
    f32x2 t = s01 * (f32x2){o.nk[0], o.nk[1]}; t = __builtin_elementwise_fma(s23, (f32x2){o.nk[2], o.nk[3]}, t);
    const float sa = row16_sum(t[0] + t[1]);
    const f32x2 sa2 = {sa, sa}, vv2 = {o.vv, o.vv};
    f32x2 u01 = (f32x2){o.k[0], o.k[1]} * vv2, u23 = (f32x2){o.k[2], o.k[3]} * vv2;
    u01 = __builtin_elementwise_fma((f32x2){o.ka[0], o.ka[1]}, sa2, u01); u23 = __builtin_elementwise_fma((f32x2){o.ka[2], o.ka[3]}, sa2, u23);
    s01 = __builtin_elementwise_fma(s01, (f32x2){o.w[0], o.w[1]}, u01); s23 = __builtin_elementwise_fma(s23, (f32x2){o.w[2], o.w[3]}, u23);
    S = (f32x4){s01[0], s01[1], s23[0], s23[1]};
    f32x2 y = s01 * (f32x2){o.r[0], o.r[1]}; y = __builtin_elementwise_fma(s23, (f32x2){o.r[2], o.r[3]}, y);
    return y[0] + y[1];
}
__device__ __forceinline__ void lds_step(StepOps& o, const LAS float* rp, int li, int row) {
    o.nk = *(const LAS f32x4*)(rp + li * 4); o.w = *(const LAS f32x4*)(rp + 64 + li * 4); o.ka = *(const LAS f32x4*)(rp + 128 + li * 4);
    o.k = *(const LAS f32x4*)(rp + 192 + li * 4); o.r = *(const LAS f32x4*)(rp + 256 + li * 4); o.vv = rp[320 + row];
}
__device__ __forceinline__ void scan_issue(const float* recs, LAS unsigned char* lb, int c, int lane) {
    const char* gp = (const char*)recs + (size_t)c * 12288 + lane * 16; LAS unsigned char* lp = lb + (c & 3) * 12288;
#pragma unroll
    for (int g = 0; g < 3; ++g) {
        __builtin_amdgcn_global_load_lds((const unsigned*)(gp + g * 4096), (LAS unsigned*)(lp + g * 4096), 16, 0, 0);
        __builtin_amdgcn_global_load_lds((const unsigned*)(gp + g * 4096), (LAS unsigned*)(lp + g * 4096), 16, 1024, 0);
        __builtin_amdgcn_global_load_lds((const unsigned*)(gp + g * 4096), (LAS unsigned*)(lp + g * 4096), 16, 2048, 0);
        __builtin_amdgcn_global_load_lds((const unsigned*)(gp + g * 4096), (LAS unsigned*)(lp + g * 4096), 16, 3072, 0);
    }
}
__device__ __forceinline__ void scan_seg(const float* recs, LAS float* lbf, f32x4& S, float* yout, int row, int ycol, int lane) {
    const int li = lane & 15; LAS unsigned char* lb = (LAS unsigned char*)lbf;
    scan_issue(recs, lb, 0, lane); scan_issue(recs, lb, 1, lane); scan_issue(recs, lb, 2, lane);
    asm volatile("s_waitcnt vmcnt(24)" ::: "memory");
    StepOps cur, n1, n2; lds_step(cur, lbf, li, row); lds_step(n1, lbf + 384, li, row);
#pragma unroll 12
    for (int c = 0; c < 64; ++c) {
        const LAS float* bcur = lbf + (c & 3) * 3072; const LAS float* bnxt = lbf + ((c + 1) & 3) * 3072;
        float yp[8];
#pragma unroll
        for (int tt = 0; tt < 8; ++tt) {
            if (tt == 1 && c + 3 < 64) scan_issue(recs, lb, c + 3, lane);
            if (tt == 5) { if (c < 61) asm volatile("s_waitcnt vmcnt(24)" ::: "memory"); else if (c == 61) asm volatile("s_waitcnt vmcnt(12)" ::: "memory"); else asm volatile("s_waitcnt vmcnt(0)" ::: "memory"); }
            if (tt < 6) lds_step(n2, bcur + (tt + 2) * 384, li, row);
            else if (c < 63) lds_step(n2, bnxt + (tt - 6) * 384, li, row);
            yp[tt] = wkv_step(S, cur);
            cur = n1; n1 = n2;
        }
        float ysel = 0.f;
#pragma unroll
        for (int tt = 0; tt < 8; ++tt) { const float y = row16_sum(yp[tt]); ysel = (li == tt) ? y : ysel; }
        if (li < 8) yout[(size_t)(c * 8 + li) * 8 + ycol] = ysel;
    }
}
__device__ __forceinline__ void scan_sample_job(PP P, int q, int lane) {
    const int bh = q >> 4, row = (q & 15) * 4 + (lane >> 4), li = lane & 15;
    f32x4 S = *(const f32x4*)(P->in[4] + ((size_t)bh * 64 + row) * 64 + li * 4);
    const float* rec = (const float*)(P->ws + SREC) + (size_t)bh * 8 * 384; float* yo = (float*)(P->ws + YRAW_S);
    float ysel = 0.f;
#pragma unroll
    for (int hb = 0; hb < 2; ++hb) {
        StepOps o[4];
#pragma unroll
        for (int t = 0; t < 4; ++t) { const float* rp = rec + (hb * 4 + t) * 384;
            o[t].nk = *(const f32x4*)(rp + li * 4); o[t].w = *(const f32x4*)(rp + 64 + li * 4); o[t].ka = *(const f32x4*)(rp + 128 + li * 4);
            o[t].k = *(const f32x4*)(rp + 192 + li * 4); o[t].r = *(const f32x4*)(rp + 256 + li * 4); o[t].vv = rp[320 + row]; }
#pragma unroll
        for (int t = 0; t < 4; ++t) { const float y = row16_sum(wkv_step(S, o[t])); ysel = (li == hb * 4 + t) ? y : ysel; }
    }
    if (li < 8) yo[((size_t)q * 8 + li) * 4 + (lane >> 4)] = ysel;
    *(f32x4*)(P->out + O_WKVS + ((size_t)bh * 64 + row) * 64 + li * 4) = S;
}

#define XB_TMO      128
#define XB_XCNT(j)  (256  + 64 * (j))
#define XB_XSUB(j)  (1280 + 64 * (j))
#define XB_XGEN(j)  (2304 + 64 * (j))
#define XB_TOP      3328
#define XB_TOPGEN   3392
#define XCD_BAR_WORDS 3456
#define XB_SPIN_CAP (1u << 18)
__device__ __forceinline__ unsigned xb_ld(unsigned* p)              { return __hip_atomic_load(p, __ATOMIC_RELAXED, __HIP_MEMORY_SCOPE_AGENT); }
__device__ __forceinline__ unsigned xb_add(unsigned* p, unsigned v) { return __hip_atomic_fetch_add(p, v, __ATOMIC_RELAXED, __HIP_MEMORY_SCOPE_AGENT); }
__device__ __forceinline__ unsigned xb_xcc_id() { return (unsigned)__builtin_amdgcn_s_getreg((3 << 11) | 20) & 0xFu; }
#define XB_SPIN(cond, bar) do { unsigned _sp = 0; while (cond) { __builtin_amdgcn_s_sleep(1); \
    if ((++_sp & 255u) == 0u) { if (xb_ld(&(bar)[XB_TMO])) break; if (_sp > XB_SPIN_CAP) { atomicAdd(&(bar)[XB_TMO], 1u); break; } } } } while (0)
struct XcdBarrier { unsigned* bar; unsigned x; volatile LAS unsigned* st; };
__device__ __forceinline__ XcdBarrier xcd_barrier_post(unsigned* bar, volatile LAS unsigned* st) {
    XcdBarrier b; b.bar = bar; b.x = xb_xcc_id(); b.st = st;
    if (threadIdx.x == 0) (void)xb_add(&bar[XB_XCNT(b.x)], 1u);
    return b;
}
__device__ __forceinline__ void xcd_barrier_complete(unsigned* bar, unsigned x, unsigned& nloc, unsigned& nx) {
    const unsigned G = gridDim.x * gridDim.y * gridDim.z;
    unsigned sum, cnt, mine, sp = 0u;
    for (;;) {
        sum = 0u; cnt = 0u; mine = 0u;
#pragma unroll
        for (unsigned j = 0; j < 16; ++j) { const unsigned c = xb_ld(&bar[XB_XCNT(j)]); sum += c; cnt += (c > 0u) ? 1u : 0u; mine = (j == x) ? c : mine; }
        if (sum == G) break;
        __builtin_amdgcn_s_sleep(1);
        if ((++sp & 255u) == 0u) { if (xb_ld(&bar[XB_TMO])) break; if (sp > XB_SPIN_CAP) { atomicAdd(&bar[XB_TMO], 1u); break; } }
    }
    nloc = mine > 0u ? mine : 1u; nx = cnt > 0u ? cnt : 1u;
}
__device__ __forceinline__ void xcd_barrier(const XcdBarrier& b) {
    asm volatile("s_waitcnt vmcnt(0)" ::: "memory");
    __syncthreads();
    if (threadIdx.x == 0) {
        unsigned* bar = b.bar;
        __builtin_amdgcn_s_waitcnt(0);
        unsigned nloc = b.st[0], nx = b.st[1];
        if (nloc == 0u) { xcd_barrier_complete(bar, b.x, nloc, nx); b.st[0] = nloc; b.st[1] = nx; }
        const unsigned old = xb_add(&bar[XB_XSUB(b.x)], 1u);
        const unsigned gen = old / nloc;
        if (old + 1u == (gen + 1u) * nloc) {
            __builtin_amdgcn_fence(__ATOMIC_RELEASE, "agent");
            asm volatile("s_waitcnt vmcnt(0)" ::: "memory");
            const unsigned og = xb_add(&bar[XB_TOP], 1u);
            const unsigned tg = og / nx;
            if (og + 1u == (tg + 1u) * nx) xb_add(&bar[XB_TOPGEN], 1u);
            else XB_SPIN(xb_ld(&bar[XB_TOPGEN]) == tg, bar);
            __builtin_amdgcn_fence(__ATOMIC_ACQUIRE, "agent");
            xb_add(&bar[XB_XGEN(b.x)], 1u);
            asm volatile("s_waitcnt vmcnt(0)" ::: "memory");
        } else {
            XB_SPIN(xb_ld(&bar[XB_XGEN(b.x)]) == gen, bar);
            __builtin_amdgcn_fence(__ATOMIC_ACQUIRE, "agent");
            asm volatile("s_waitcnt vmcnt(0)" ::: "memory");
        }
    }
    __syncthreads();
}
__device__ __forceinline__ f32x4 part_sum(const float* part, int s0, int ns, int rl, int c) {
    f32x4 a = *(const f32x4*)(part + ((size_t)s0 * 256 + rl) * DM + c);
    for (int s = 1; s < ns; ++s) a += *(const f32x4*)(part + ((size_t)(s0 + s) * 256 + rl) * DM + c);
    return a;
}
__device__ __forceinline__ void ssq_store(float* ssq, const f32x4 x, int r, int t) {
    const float ss = row16_sum(x[0] * x[0] + x[1] * x[1] + x[2] * x[2] + x[3] * x[3]);
    if ((t & 15) == 0) ssq[((size_t)(t >> 6) * MTOK + r) * 4 + ((t & 63) >> 4)] = ss;
}
#define CG_SYNC() do { asm volatile("s_waitcnt vmcnt(0) lgkmcnt(0)" ::: "memory"); grid.sync(); \
    __builtin_amdgcn_fence(__ATOMIC_ACQUIRE, "agent"); asm volatile("s_waitcnt vmcnt(0)" ::: "memory"); } while (0)
#define GRID_SYNC() xcd_barrier(xbar)
__global__ void __launch_bounds__(512) fwd_megakernel(Params Pk) {
    extern __shared__ __attribute__((aligned(16))) unsigned char smem_raw[];
    LAS unsigned char* lds = (LAS unsigned char*)smem_raw;
    cg::grid_group grid = cg::this_grid();
    volatile LAS unsigned* xst = (volatile LAS unsigned*)(lds + 131072);
    if (threadIdx.x == 0) { xst[0] = 0u; xst[1] = 0u; }
    __syncthreads();
    const XcdBarrier xbar = xcd_barrier_post((unsigned*)(fresh_params()->ws + XBAR), xst);
#if (PHMASK >> 0) & 1
    { PP P = fresh_params(); char* ws = P->ws; const int tid = threadIdx.x, lane = tid & 63, wid = __builtin_amdgcn_readfirstlane(tid >> 6); Sched S; (void)lane; (void)wid; (void)S; (void)ws;
    phase0(P, lds);
    if (P->out == nullptr) CG_SYNC();
    }
    GRID_SYNC();
#endif
#ifdef DUMP_OFF
    if (DUMP_AT == 1) { PP P = fresh_params(); const bf16_t* src = (const bf16_t*)(P->ws + DUMP_OFF); float* o = P->out + 16000000;
        for (size_t i = (size_t)blockIdx.x * 512 + threadIdx.x; i < DUMP_N; i += (size_t)gridDim.x * 512) o[i] = DUMP_F32 == 2 ? ((const float*)src)[(i >> 6) * 384 + DUMP_STRIDE * 64 + (i & 63)] : DUMP_F32 ? ((const float*)src)[i * DUMP_STRIDE] : bf2f(src[i * DUMP_STRIDE]);
        return; }
#endif
#if (PHMASK >> 1) & 1
    { PP P = fresh_params(); char* ws = P->ws; const int tid = threadIdx.x, lane = tid & 63, wid = __builtin_amdgcn_readfirstlane(tid >> 6); Sched S; (void)lane; (void)wid; (void)S; (void)ws;
    { S.init(MTOK, 9216, 2048, ws + HBUF, ws + WT_IN);
      EpiIn E{(bf16_t*)(ws + QB), (bf16_t*)(ws + KP), (bf16_t*)(ws + VP), (bf16_t*)(ws + KS), (bf16_t*)(ws + VS), (bf16_t*)((char*)P->out + O_COLS), (bf16_t*)(ws + GA), (bf16_t*)(ws + GR), P->out};
      gemm_phase(lds, opaque(2048), S, E);
      const int G_ = (int)gridDim.x, nfull = S.nwg % G_;
      if (nfull > 0) { if ((int)blockIdx.x >= nfull) phase0_late(P, blockIdx.x - nfull, G_ - nfull); }
      else phase0_late(P, blockIdx.x, G_); }
    }
    GRID_SYNC();
#endif
#ifdef DUMP_OFF
    if (DUMP_AT == 2) { PP P = fresh_params(); const bf16_t* src = (const bf16_t*)(P->ws + DUMP_OFF); float* o = P->out + 16000000;
        for (size_t i = (size_t)blockIdx.x * 512 + threadIdx.x; i < DUMP_N; i += (size_t)gridDim.x * 512) o[i] = DUMP_F32 == 2 ? ((const float*)src)[(i >> 6) * 384 + DUMP_STRIDE * 64 + (i & 63)] : DUMP_F32 ? ((const float*)src)[i * DUMP_STRIDE] : bf2f(src[i * DUMP_STRIDE]);
        return; }
#endif
#if (PHMASK >> 2) & 1
    { PP P = fresh_params(); char* ws = P->ws; const int tid = threadIdx.x, lane = tid & 63, wid = __builtin_amdgcn_readfirstlane(tid >> 6); Sched S; (void)lane; (void)wid; (void)S; (void)ws;
    lora_a_phase(P);
#ifndef NOATTN
    if (wid >= 2) { LAS bf16_t* vt = (LAS bf16_t*)(lds + (wid - 2) * VT_BYTES); const int npw = gridDim.x * 6;
        for (int job = blockIdx.x * 6 + (wid - 2); job < 2048 + 128; job += npw) attn_job(P, vt, job, lane); }
#endif
    }
    GRID_SYNC();
#endif
#ifdef DUMP_OFF
    if (DUMP_AT == 3) { PP P = fresh_params(); const bf16_t* src = (const bf16_t*)(P->ws + DUMP_OFF); float* o = P->out + 16000000;
        for (size_t i = (size_t)blockIdx.x * 512 + threadIdx.x; i < DUMP_N; i += (size_t)gridDim.x * 512) o[i] = DUMP_F32 == 2 ? ((const float*)src)[(i >> 6) * 384 + DUMP_STRIDE * 64 + (i & 63)] : DUMP_F32 ? ((const float*)src)[i * DUMP_STRIDE] : bf2f(src[i * DUMP_STRIDE]);
        return; }
#endif
#if (PHMASK >> 3) & 1
    { PP P = fresh_params(); char* ws = P->ws; const int tid = threadIdx.x, lane = tid & 63, wid = __builtin_amdgcn_readfirstlane(tid >> 6); Sched S; (void)lane; (void)wid; (void)S; (void)ws;
    { S.init(MTOK, 3072, 384, (char*)P->out + O_LORA_A, ws + WT_LORA);
      EpiLora E{(bf16_t*)(ws + LORA_OUT), P->in[12], P->in[14]};
      gemm_phase(lds, opaque(384), S, E); }
    }
    GRID_SYNC();
#endif
#ifdef DUMP_OFF
    if (DUMP_AT == 4) { PP P = fresh_params(); const bf16_t* src = (const bf16_t*)(P->ws + DUMP_OFF); float* o = P->out + 16000000;
        for (size_t i = (size_t)blockIdx.x * 512 + threadIdx.x; i < DUMP_N; i += (size_t)gridDim.x * 512) o[i] = DUMP_F32 == 2 ? ((const float*)src)[(i >> 6) * 384 + DUMP_STRIDE * 64 + (i & 63)] : DUMP_F32 ? ((const float*)src)[i * DUMP_STRIDE] : bf2f(src[i * DUMP_STRIDE]);
        return; }
#endif
#if (PHMASK >> 4) & 1
    { PP P = fresh_params(); char* ws = P->ws; const int tid = threadIdx.x, lane = tid & 63, wid = __builtin_amdgcn_readfirstlane(tid >> 6); Sched S; (void)lane; (void)wid; (void)S; (void)ws;
    {
        const int B = blockIdx.x, xcd = B & 7, slot = B >> 3, bh = xcd * 4 + (slot >> 3), rq8 = slot & 7, rowb = rq8 * 8 + (wid & 1) * 4 + (lane >> 4);
        const bool scanner = wid < 2 && slot < 32;
        f32x4 St = (f32x4){0.f, 0.f, 0.f, 0.f};
        const int pw = B * 4 + ((wid & 1) | ((wid & 4) >> 1)), npw = gridDim.x * 4;
        for (int s = 0; s < 10; ++s) {
            if (s == 0) {
                for (int ti = B * 8 + wid; ti < 1024 + 256; ti += (int)gridDim.x * 8) {
                    if (ti < 1024) { const int b = ti >> 9, t = ti & 511;
                        prep_token(P, b * 4096 + t, lane, (float*)(ws + SEG) + ((size_t)(b * 16) * 512 + t) * 384, (size_t)512 * 384); }
                    else { const int tj = ti - 1024, b = tj >> 3, t = tj & 7;
                        prep_token(P, MPR + tj, lane, (float*)(ws + SREC) + ((size_t)(b * 16) * 8 + t) * 384, (size_t)8 * 384); } }
            } else if (wid < 2) {
                if (scanner && s >= 1 && s <= 8) { const int j = s - 1; __builtin_amdgcn_s_setprio(3);
                    scan_seg((const float*)(ws + SEG + (size_t)(j & 1) * SEG_SZ) + (size_t)bh * 512 * 384, (LAS float*)(lds + wid * 49152), St,
                             (float*)(ws + YRAW) + (size_t)(j & 1) * 1048576 + (size_t)(bh * 8 + rq8) * 4096, rowb, (wid & 1) * 4 + (lane >> 4), lane);
                    if (s == 8) *(f32x4*)(P->out + O_WKVP + ((size_t)bh * 64 + rowb) * 64 + (lane & 15) * 4) = St; __builtin_amdgcn_s_setprio(0); }
            } else if (wid != 4 && wid != 5) {
                if (s >= 1 && s < 8) for (int ti = pw; ti < 1024; ti += npw) { const int b = ti >> 9, t = ti & 511;
                    prep_token(P, b * 4096 + s * 512 + t, lane, (float*)(ws + SEG + (size_t)(s & 1) * SEG_SZ) + ((size_t)(b * 16) * 512 + t) * 384, (size_t)512 * 384); }
                if (s == 1) for (int job = pw; job < 8192; job += npw) scan_sample_job(P, job, lane);
                if (s >= 2) { const int j = s - 2; const float* ring = (const float*)(ws + YRAW) + (size_t)(j & 1) * 1048576;
                    for (int ti = pw; ti < 1024; ti += npw) { const int b = ti >> 9, t = ti & 511, hd = lane >> 2, sub = lane & 3; f32x4 y[4];
#pragma unroll
                        for (int q = 0; q < 4; ++q) y[q] = *(const f32x4*)(ring + ((size_t)((b * 16 + hd) * 8 + sub * 2 + (q >> 1)) * 512 + t) * 8 + (q & 1) * 4);
                        post_token(P, b * 4096 + j * 512 + t, lane, y); } }
                if (s >= 2 && s <= 8) {
                    const int hidx = (wid & 1) | ((wid & 4) >> 1); LAS float* ctile = (LAS float*)(hidx < 3 ? lds + 98304 + hidx * 9216 : lds + 131104);
                    const int slot = (s - 2) * npw + pw, nslots = 7 * npw;
                    const int widx[7] = {26, 27, 24, 29, 22, 23, 28}; const size_t wdst[7] = {WT_UP, WT_DN, WT_OUT, WT_PG, WT_BA, WT_BR, WT_PP};
                    const int wk[7] = {2048, 8192, 2048, 2048, 1024, 1024, 256}, wn[7] = {8192, 2048, 2048, 2048, 2048, 2048, 2048};
#pragma unroll
                    for (int j = 0; j < 7; ++j) { ConvJob J; J.src = P->in[widx[j]]; J.dst = (bf16_t*)(ws + wdst[j]); J.K = wk[j]; J.N = wn[j]; J.nNt = wn[j] >> 5; J.ntile = (wk[j] >> 6) * J.nNt;
                        conv_wave_run(J, (slot + j * 1171) % nslots, nslots, lane, ctile); }
                }
                if (s == 2) for (int ti = pw; ti < 256; ti += npw) { const int b = ti >> 3, t = ti & 7, hd = lane >> 2, sub = lane & 3; f32x4 y[4];
#pragma unroll
                    for (int q = 0; q < 4; ++q) y[q] = *(const f32x4*)((const float*)(ws + YRAW_S) + ((size_t)((b * 16 + hd) * 16 + sub * 4 + q) * 8 + t) * 4);
                    post_token(P, MPR + ti, lane, y); }
            }
            GRID_SYNC();
        }
    }
    }
#endif
#ifdef DUMP_OFF
    if (DUMP_AT == 5) { PP P = fresh_params(); const bf16_t* src = (const bf16_t*)(P->ws + DUMP_OFF); float* o = P->out + 16000000;
        for (size_t i = (size_t)blockIdx.x * 512 + threadIdx.x; i < DUMP_N; i += (size_t)gridDim.x * 512) o[i] = DUMP_F32 == 2 ? ((const float*)src)[(i >> 6) * 384 + DUMP_STRIDE * 64 + (i & 63)] : DUMP_F32 ? ((const float*)src)[i * DUMP_STRIDE] : bf2f(src[i * DUMP_STRIDE]);
        return; }
#endif
#if (PHMASK >> 5) & 1
    { PP P = fresh_params(); char* ws = P->ws; const int tid = threadIdx.x, lane = tid & 63, wid = __builtin_amdgcn_readfirstlane(tid >> 6); Sched S; (void)lane; (void)wid; (void)S; (void)ws;
    { S.init(MTOK, 2048, 1024, ws + YA, ws + WT_BA); S.dual = 1; S.A1 = ws + YR; S.B1 = ws + WT_BR;
      EpiMix E{(const bf16_t*)(ws + GA), (const bf16_t*)(ws + GR), (bf16_t*)(ws + MIXED), P->out};
      S.set_tail(4); S.nosub = 1;
      gemm_phase(lds, opaque(1024), S, E);
      Sched S2; S2.init(MTOK, 2048, 1024, ws + YA, ws + WT_BA); S2.A1 = ws + YR; S2.B1 = ws + WT_BR; S2.set_tail(4); S2.ngem = 2; S2.tail_i = 0; S2.part = (float*)(ws + SEG);
      EpiNone E2{}; gemm_phase(lds, opaque(1024), S2, E2); }
    }
    GRID_SYNC();
    { PP P = fresh_params(); char* ws = P->ws; const int t = threadIdx.x, rl = blockIdx.x;
      if (rl < 256) { const int c = t * 4; const size_t o = (size_t)(MPR + rl) * DM + c; const float* part = (const float*)(ws + SEG);
        const f32x4 a0 = part_sum(part, 0, 4, rl, c), a1 = part_sum(part, 4, 4, rl, c);
        const f32x4 ga = unpack4(*(const u32x2*)((const bf16_t*)(ws + GA) + o)), gr = unpack4(*(const u32x2*)((const bf16_t*)(ws + GR) + o));
        *(u32x2*)((bf16_t*)(ws + MIXED) + o) = pack4(ga * a0 + gr * a1); }
    }
    GRID_SYNC();
#endif
#ifdef DUMP_OFF
    if (DUMP_AT == 6) { PP P = fresh_params(); const bf16_t* src = (const bf16_t*)(P->ws + DUMP_OFF); float* o = P->out + 16000000;
        for (size_t i = (size_t)blockIdx.x * 512 + threadIdx.x; i < DUMP_N; i += (size_t)gridDim.x * 512) o[i] = DUMP_F32 == 2 ? ((const float*)src)[(i >> 6) * 384 + DUMP_STRIDE * 64 + (i & 63)] : DUMP_F32 ? ((const float*)src)[i * DUMP_STRIDE] : bf2f(src[i * DUMP_STRIDE]);
        return; }
#endif
#if (PHMASK >> 6) & 1
    { PP P = fresh_params(); char* ws = P->ws; const int tid = threadIdx.x, lane = tid & 63, wid = __builtin_amdgcn_readfirstlane(tid >> 6); Sched S; (void)lane; (void)wid; (void)S; (void)ws;
    { S.init(MTOK, 2048, 2048, ws + MIXED, ws + WT_OUT);
      EpiOut E{P->in[0], P->in[1], P->in[25], (bf16_t*)(ws + X1), (float*)(ws + SSQ1), (bf16_t*)(ws + HN)};
      S.set_tail(8); S.part = (float*)(ws + YR);
      gemm_phase(lds, opaque(2048), S, E); }
    }
    GRID_SYNC();
    { PP P = fresh_params(); char* ws = P->ws; const int t = threadIdx.x, rl = blockIdx.x;
      if (rl < 256) { const int c = t * 4, r = MPR + rl; const size_t o = (size_t)r * DM + c;
        const f32x4 x = *(const f32x4*)(P->in[1] + (size_t)rl * DM + c) + part_sum((const float*)(ws + YR), 0, 8, rl, c);
        *(u32x2*)((bf16_t*)(ws + X1) + o) = pack4(x); *(u32x2*)((bf16_t*)(ws + HN) + o) = pack4(x * *(const f32x4*)(P->in[25] + c));
        ssq_store((float*)(ws + SSQ1), x, r, t); }
    }
    GRID_SYNC();
#endif
#ifdef DUMP_OFF
    if (DUMP_AT == 7) { PP P = fresh_params(); const bf16_t* src = (const bf16_t*)(P->ws + DUMP_OFF); float* o = P->out + 16000000;
        for (size_t i = (size_t)blockIdx.x * 512 + threadIdx.x; i < DUMP_N; i += (size_t)gridDim.x * 512) o[i] = DUMP_F32 == 2 ? ((const float*)src)[(i >> 6) * 384 + DUMP_STRIDE * 64 + (i & 63)] : DUMP_F32 ? ((const float*)src)[i * DUMP_STRIDE] : bf2f(src[i * DUMP_STRIDE]);
        return; }
#endif
#if (PHMASK >> 7) & 1
    { PP P = fresh_params(); char* ws = P->ws; const int tid = threadIdx.x, lane = tid & 63, wid = __builtin_amdgcn_readfirstlane(tid >> 6); Sched S; (void)lane; (void)wid; (void)S; (void)ws;
    { S.init(MTOK, 8192, 2048, ws + HN, ws + WT_UP); S.set_tail(4); S.part = (float*)(ws + R12);
      float* rsb = (float*)(ws + RSB) + (size_t)blockIdx.x * 2048;
      { const float* ssq = (const float*)(ws + SSQ1); Unit u;
        for (int i = 0; i < 8 && S.next(i, u); ++i) if (tid < 256) { const int r = u.pm * BM + tid; const f32x4* sp = (const f32x4*)ssq + r; f32x4 t = sp[0];
#pragma unroll
            for (int k = 1; k < 8; ++k) t += sp[(size_t)k * MTOK];
            rsb[i * 256 + tid] = rsqrtf((t[0] + t[1] + t[2] + t[3]) * (1.0f / 2048.0f) + 1e-6f); }
        asm volatile("s_waitcnt vmcnt(0)" ::: "memory"); __syncthreads(); }
      EpiUp E{rsb, (bf16_t*)P->out, (bf16_t*)(ws + ACTB)};
      gemm_phase(lds, opaque(2048), S, E); }
    }
    GRID_SYNC();
    { PP P = fresh_params(); char* ws = P->ws; const int t = threadIdx.x, rl = blockIdx.x;
      if (rl < 256) { const int r = MPR + rl; const float* ssq = (const float*)(ws + SSQ1); const float* part = (const float*)(ws + R12);
        float tq = 0.f;
#pragma unroll
        for (int k = 0; k < 8; ++k) { const f32x4 q = *((const f32x4*)ssq + (size_t)k * MTOK + r); tq += (q[0] + q[1]) + (q[2] + q[3]); }
        const float rs = rsqrtf(tq * (1.0f / 2048.0f) + 1e-6f);
        bf16_t* dst = (bf16_t*)(ws + ACTB) + (size_t)(r - ACT_SPLIT * BM) * 8192;
        for (int c = t * 4; c < 8192; c += 2048) { f32x4 a = *(const f32x4*)(part + (size_t)rl * 8192 + c);
#pragma unroll
            for (int sl = 1; sl < 4; ++sl) a += *(const f32x4*)(part + ((size_t)sl * 256 + rl) * 8192 + c);
#pragma unroll
            for (int j = 0; j < 4; ++j) { const float z = fmaxf(a[j] * rs, 0.f); a[j] = z * z; }
            *(u32x2*)(dst + c) = pack4(a); } }
    }
    GRID_SYNC();
#endif
#if (PHMASK >> 8) & 1
    { PP P = fresh_params(); char* ws = P->ws; const int tid = threadIdx.x, lane = tid & 63, wid = __builtin_amdgcn_readfirstlane(tid >> 6); Sched S; (void)lane; (void)wid; (void)S; (void)ws;
    { S.init(MTOK, 2048, 8192, P->out, ws + WT_DN); S.splitpm = ACT_SPLIT; S.A0b = ws + ACTB;
      EpiDown E{(const bf16_t*)(ws + X1), (bf16_t*)(ws + X2B)};
      S.set_tail(8); S.part = (float*)(ws + YR);
      gemm_phase(lds, opaque(8192), S, E);
      if (blockIdx.x >= 64) {
          Sched SP; SP.init(MTOK, 2048, 256, ws + PEB, ws + WT_PP); SP.G = gridDim.x - 64; SP.c = blockIdx.x - 64;
          EpiP E0{(bf16_t*)(ws + PBUF)}; gemm_phase(lds, opaque(256), SP, E0); } }
    }
    GRID_SYNC();
    { PP P = fresh_params(); char* ws = P->ws; const int t = threadIdx.x, rl = blockIdx.x;
      if (rl < 256) { const int c = t * 4; const size_t o = (size_t)(MPR + rl) * DM + c;
        const f32x4 x = unpack4(*(const u32x2*)((const bf16_t*)(ws + X1) + o)) + part_sum((const float*)(ws + YR), 0, 8, rl, c);
        *(u32x2*)((bf16_t*)(ws + X2B) + o) = pack4(x); }
    }
    GRID_SYNC();
#endif
#if (PHMASK >> 9) & 1
    { PP P = fresh_params(); char* ws = P->ws; const int tid = threadIdx.x, lane = tid & 63, wid = __builtin_amdgcn_readfirstlane(tid >> 6); Sched S; (void)lane; (void)wid; (void)S; (void)ws;
    {
      S.init(MTOK, 2048, 2048, ws + X2B, ws + WT_PG);
      EpiGate E{(const bf16_t*)(ws + X2B), (const bf16_t*)(ws + PBUF), (bf16_t*)(ws + R3), (float*)(ws + SSQ2)};
      S.set_tail(8); S.part = (float*)(ws + YR);
      gemm_phase(lds, opaque(2048), S, E); }
    }
    GRID_SYNC();
    { PP P = fresh_params(); char* ws = P->ws; const int t = threadIdx.x, rl = blockIdx.x;
      if (rl < 256) { const int c = t * 4, r = MPR + rl; const size_t o = (size_t)r * DM + c; LAS float* red = (LAS float*)lds;
        const f32x4 a = part_sum((const float*)(ws + YR), 0, 8, rl, c), p = unpack4(*(const u32x2*)((const bf16_t*)(ws + PBUF) + o)); f32x4 x = unpack4(*(const u32x2*)((const bf16_t*)(ws + X2B) + o));
#pragma unroll
        for (int j = 0; j < 4; ++j) x[j] += sigmoidf_(a[j]) * p[j];
        const float ws_ = wave_sum(x[0] * x[0] + x[1] * x[1] + x[2] * x[2] + x[3] * x[3]);
        if ((t & 63) == 0) red[t >> 6] = ws_;
        __syncthreads();
        float tot = 0.f;
#pragma unroll
        for (int k = 0; k < 8; ++k) tot += red[k];
        const float rs = rsqrtf(tot * (1.0f / 2048.0f) + 1e-6f);
        *(f32x4*)(P->out + o) = x * rs * *(const f32x4*)(P->in[30] + c); }
      __syncthreads();
    }
#endif
#if (PHMASK >> 10) & 1
    { PP P = fresh_params(); char* ws = P->ws; const int tid = threadIdx.x, lane = tid & 63, wid = __builtin_amdgcn_readfirstlane(tid >> 6); Sched S; (void)lane; (void)wid; (void)S; (void)ws;
    { const float* gf = P->in[30]; const float* ssq = (const float*)(ws + SSQ2);
      for (int r = blockIdx.x * 8 + wid; r < MPR; r += gridDim.x * 8) {
          float t = lane < 32 ? ssq[((size_t)(lane >> 2) * MTOK + r) * 4 + (lane & 3)] : 0.f; t = wave_sum(t); const float rs = rsqrtf(t * (1.0f / 2048.0f) + 1e-6f);
          float* x = P->out + (size_t)r * DM; const bf16_t* xb = (const bf16_t*)(ws + R3) + (size_t)r * DM;
#pragma unroll
          for (int i = 0; i < 8; ++i) { const f32x4 v = unpack4(*(const u32x2*)(xb + i * 256 + lane * 4)), g = *(const f32x4*)(gf + i * 256 + lane * 4); *(f32x4*)(x + i * 256 + lane * 4) = v * rs * g; }
      } }
    }
#endif
}

extern "C" void kernel_launch(void* const* d_in, const int* in_sizes, int n_in, void* d_out, int out_size, void* d_ws, size_t ws_size, hipStream_t stream) {
    static int grid_blocks = 0;
    if (!grid_blocks) {
        int dev = 0, cus = 0, per_cu = 0;
        hipGetDevice(&dev);
        hipFuncSetAttribute((const void*)fwd_megakernel, hipFuncAttributeMaxDynamicSharedMemorySize, (int)LDS_BYTES);
        hipDeviceGetAttribute(&cus, hipDeviceAttributeMultiprocessorCount, dev);
        hipOccupancyMaxActiveBlocksPerMultiprocessor(&per_cu, fwd_megakernel, 512, LDS_BYTES);
        grid_blocks = cus * (per_cu > 0 ? 1 : 0);
        if (grid_blocks > 256) grid_blocks = 256;
        if (ws_size < WS_END) fprintf(stderr, "workspace too small: %zu < %zu\n", ws_size, (size_t)WS_END);
    }
    Params p{};
    for (int i = 0; i < 31; ++i) p.in[i] = (const float*)d_in[i];
    p.out = (float*)d_out; p.ws = (char*)d_ws;
    (void)hipMemsetAsync((char*)d_ws + XBAR, 0, XCD_BAR_WORDS * sizeof(unsigned), stream);
    void* args[] = {&p};
    hipError_t e = hipLaunchCooperativeKernel((const void*)fwd_megakernel, dim3(grid_blocks), dim3(512), args, LDS_BYTES, stream);
    if (e != hipSuccess) fprintf(stderr, "cooperative launch failed: %s (grid %d)\n", hipGetErrorString(e), grid_blocks);
}
```
